# Optimizing an MI355X kernel written in HIP

```python
import math
import jax, jax.numpy as jnp
from jax import lax
import numpy as np

D_MODEL = 1024
BATCH = 32
SEQ = 2048
DEPTH = 2
DEC_BATCH = 4
DEC_SEQ = 4096
PAST_LEN = 128

GRID_W = 64
HEAD_DIM = 64
AXIAL_DIM = HEAD_DIM // 2
GQA_HEADS = 8
GQA_KV_HEADS = 2
GQA_GROUP = GQA_HEADS // GQA_KV_HEADS
DIFF_HEADS = 4
DIFF_V_DIM = 2 * HEAD_DIM
GQA_Q = GQA_HEADS * HEAD_DIM
GQA_KV = GQA_KV_HEADS * HEAD_DIM
DIFF_QK = DIFF_HEADS * 2 * HEAD_DIM
DIFF_V = DIFF_HEADS * DIFF_V_DIM
MIX_WIDTH = GQA_Q + DIFF_V
IN_WIDTH = GQA_Q + 2 * GQA_KV + 2 * DIFF_QK + DIFF_V
SPLITS = (GQA_Q, GQA_Q + GQA_KV, GQA_Q + 2 * GQA_KV, GQA_Q + 2 * GQA_KV + DIFF_QK, GQA_Q + 2 * GQA_KV + 2 * DIFF_QK)
D_FF = ((8 * D_MODEL + 3 * 256 - 1) // (3 * 256)) * 256
ROPE_THETA = 10000.0
Q_BLOCK = 128
NORM_EPS = 1e-6
DIFF_NORM_EPS = 1e-5

kernel_name = "hybrid_gqa_axial_diffattn_encoder"


def rms_norm(x, g, eps):
    xf = x.astype(jnp.float32)
    y = xf * lax.rsqrt(jnp.mean(xf * xf, axis=-1, keepdims=True) + eps)
    return (y * g.astype(jnp.float32)).astype(x.dtype)


def rope_angles(pos, dim):
    inv = ROPE_THETA ** (-jnp.arange(0, dim, 2, dtype=jnp.float32) / dim)
    ang = pos.astype(jnp.float32)[:, None] * inv[None, :]
    return jnp.cos(ang), jnp.sin(ang)


def apply_rope(x, cos, sin):
    half = x.shape[-1] // 2
    shp = (1, x.shape[1]) + (1,) * (x.ndim - 3) + (half,)
    c = cos.reshape(shp).astype(x.dtype)
    s = sin.reshape(shp).astype(x.dtype)
    x1, x2 = x[..., :half], x[..., half:]
    return jnp.concatenate([x1 * c - x2 * s, x1 * s + x2 * c], axis=-1)


def to_blocks(a):
    B, S = a.shape[:2]
    return jnp.moveaxis(a.reshape((B, S // Q_BLOCK, Q_BLOCK) + a.shape[2:]), 1, 0)


def from_blocks(o):
    o = jnp.moveaxis(o, 0, 1)
    return o.reshape((o.shape[0], o.shape[1] * o.shape[2]) + o.shape[3:])


def gqa_attention(q, k, v):
    scale = HEAD_DIM ** -0.5

    def block(qb):
        s = jnp.einsum('bqkgd,bskd->bkgqs', qb, k).astype(jnp.float32) * scale
        p = jax.nn.softmax(s, axis=-1).astype(v.dtype)
        return jnp.einsum('bkgqs,bskd->bqkgd', p, v)

    return from_blocks(lax.map(block, to_blocks(q)))


def diff_attention(q1, q2, k1, k2, v, lam):
    scale = HEAD_DIM ** -0.5

    def block(qs):
        q1b, q2b = qs
        s1 = jnp.einsum('bqhd,bshd->bhqs', q1b, k1).astype(jnp.float32) * scale
        s2 = jnp.einsum('bqhd,bshd->bhqs', q2b, k2).astype(jnp.float32) * scale
        p = (jax.nn.softmax(s1, axis=-1) - lam * jax.nn.softmax(s2, axis=-1)).astype(v.dtype)
        return jnp.einsum('bhqs,bshe->bqhe', p, v)

    return from_blocks(lax.map(block, (to_blocks(q1), to_blocks(q2))))


def encoder_layer(x, layer_idx, axial_cs, seq_cs, w_in, w_out, attn_norm, gqa_q_norm, gqa_k_norm,
                  lq1, lk1, lq2, lk2, diff_sub_norm, ffn_norm, w_gate_up, w_down):
    B, S, _ = x.shape
    (row_c, row_s, col_c, col_s) = axial_cs
    (t_c, t_s) = seq_cs
    h = rms_norm(x, attn_norm, NORM_EPS)
    proj = h @ w_in
    q_g, k_g, v_g, q_d, k_d, v_d = jnp.split(proj, SPLITS, axis=-1)

    q_g = rms_norm(q_g.reshape(B, S, GQA_HEADS, HEAD_DIM), gqa_q_norm, NORM_EPS)
    k_g = rms_norm(k_g.reshape(B, S, GQA_KV_HEADS, HEAD_DIM), gqa_k_norm, NORM_EPS)
    v_g = v_g.reshape(B, S, GQA_KV_HEADS, HEAD_DIM)

    def axial(a):
        return jnp.concatenate([apply_rope(a[..., :AXIAL_DIM], row_c, row_s),
                                apply_rope(a[..., AXIAL_DIM:], col_c, col_s)], axis=-1)

    q_g = axial(q_g).reshape(B, S, GQA_KV_HEADS, GQA_GROUP, HEAD_DIM)
    k_g = axial(k_g)
    o_g = gqa_attention(q_g, k_g, v_g).reshape(B, S, GQA_Q)

    q_d = apply_rope(q_d.reshape(B, S, DIFF_HEADS, 2, HEAD_DIM), t_c, t_s)
    k_d = apply_rope(k_d.reshape(B, S, DIFF_HEADS, 2, HEAD_DIM), t_c, t_s)
    v_d = v_d.reshape(B, S, DIFF_HEADS, DIFF_V_DIM)
    lambda_init = 0.8 - 0.6 * math.exp(-0.3 * layer_idx)
    lam = (jnp.exp(jnp.sum(lq1.astype(jnp.float32) * lk1.astype(jnp.float32)))
           - jnp.exp(jnp.sum(lq2.astype(jnp.float32) * lk2.astype(jnp.float32))) + lambda_init)
    o_d = diff_attention(q_d[..., 0, :], q_d[..., 1, :], k_d[..., 0, :], k_d[..., 1, :], v_d, lam)
    o_d = (rms_norm(o_d, diff_sub_norm, DIFF_NORM_EPS) * (1.0 - lambda_init)).reshape(B, S, DIFF_V)

    x = x + jnp.concatenate([o_g, o_d], axis=-1) @ w_out

    h = rms_norm(x, ffn_norm, NORM_EPS)
    gate, up = jnp.split(h @ w_gate_up, 2, axis=-1)
    return x + (jax.nn.silu(gate) * up) @ w_down


def encoder_trunk(x, w_in, w_out, attn_norm, gqa_q_norm, gqa_k_norm, diff_lambda_q1, diff_lambda_k1,
                  diff_lambda_q2, diff_lambda_k2, diff_sub_norm, ffn_norm, w_gate_up, w_down, final_norm):
    S = x.shape[1]
    rows = S // GRID_W
    row = jnp.repeat(jnp.arange(rows, dtype=jnp.int32), GRID_W)
    col = jnp.tile(jnp.arange(GRID_W, dtype=jnp.int32), rows)
    t = jnp.arange(S, dtype=jnp.int32)
    row_c, row_s = rope_angles(row, AXIAL_DIM)
    col_c, col_s = rope_angles(col, AXIAL_DIM)
    t_c, t_s = rope_angles(t, HEAD_DIM)
    for l in range(DEPTH):
        x = encoder_layer(x, l, (row_c, row_s, col_c, col_s), (t_c, t_s), w_in[l], w_out[l], attn_norm[l],
                          gqa_q_norm[l], gqa_k_norm[l], diff_lambda_q1[l], diff_lambda_k1[l],
                          diff_lambda_q2[l], diff_lambda_k2[l], diff_sub_norm[l], ffn_norm[l],
                          w_gate_up[l], w_down[l])
    return rms_norm(x, final_norm, NORM_EPS)


def setup_inputs(seed: int = 0) -> dict:
    key = jax.random.key(seed)
    ks = jax.random.split(key, 18)
    f32 = jnp.float32

    def gain(k, shape):
        return 1.0 + 0.02 * jax.random.normal(k, shape, f32)

    return {
        "x_prompt": jax.random.normal(ks[0], (BATCH, SEQ, D_MODEL), f32),
        "x_sample": jax.random.normal(ks[1], (DEC_BATCH, DEC_SEQ, D_MODEL), f32),
        "w_in": jax.random.normal(ks[2], (DEPTH, D_MODEL, IN_WIDTH), f32) * D_MODEL ** -0.5,
        "w_out": jax.random.normal(ks[3], (DEPTH, MIX_WIDTH, D_MODEL), f32) * MIX_WIDTH ** -0.5,
        "attn_norm": gain(ks[4], (DEPTH, D_MODEL)),
        "gqa_q_norm": gain(ks[5], (DEPTH, HEAD_DIM)),
        "gqa_k_norm": gain(ks[6], (DEPTH, HEAD_DIM)),
        "diff_lambda_q1": 0.1 * jax.random.normal(ks[7], (DEPTH, HEAD_DIM), f32),
        "diff_lambda_k1": 0.1 * jax.random.normal(ks[8], (DEPTH, HEAD_DIM), f32),
        "diff_lambda_q2": 0.1 * jax.random.normal(ks[9], (DEPTH, HEAD_DIM), f32),
        "diff_lambda_k2": 0.1 * jax.random.normal(ks[10], (DEPTH, HEAD_DIM), f32),
        "diff_sub_norm": gain(ks[11], (DEPTH, DIFF_V_DIM)),
        "ffn_norm": gain(ks[12], (DEPTH, D_MODEL)),
        "w_gate_up": jax.random.normal(ks[13], (DEPTH, D_MODEL, 2 * D_FF), f32) * D_MODEL ** -0.5,
        "w_down": jax.random.normal(ks[14], (DEPTH, D_FF, D_MODEL), f32) * D_FF ** -0.5,
        "final_norm": gain(ks[15], (D_MODEL,)),
    }


def reference(x_prompt, x_sample, w_in, w_out, attn_norm, gqa_q_norm, gqa_k_norm, diff_lambda_q1,
              diff_lambda_k1, diff_lambda_q2, diff_lambda_k2, diff_sub_norm, ffn_norm, w_gate_up, w_down,
              final_norm):
    y_prompt = encoder_trunk(x_prompt, w_in, w_out, attn_norm, gqa_q_norm, gqa_k_norm, diff_lambda_q1,
                             diff_lambda_k1, diff_lambda_q2, diff_lambda_k2, diff_sub_norm, ffn_norm,
                             w_gate_up, w_down, final_norm)
    y_sample = encoder_trunk(x_sample, w_in, w_out, attn_norm, gqa_q_norm, gqa_k_norm, diff_lambda_q1,
                             diff_lambda_k1, diff_lambda_q2, diff_lambda_k2, diff_sub_norm, ffn_norm,
                             w_gate_up, w_down, final_norm)
    return (y_prompt, y_sample)
```

```cpp
#include <hip/hip_runtime.h>
#include <hip/hip_cooperative_groups.h>
#include <cstdio>
#include <cstdint>
namespace pg8 {
#define PG8_LAS __attribute__((address_space(3)))
typedef unsigned short bf16_t;
typedef short bf16x8 __attribute__((ext_vector_type(8)));
typedef float f32x4 __attribute__((ext_vector_type(4)));
typedef unsigned u32x4 __attribute__((ext_vector_type(4)));
constexpr int BM = 256, BK = 64, HALF = 128, HTB = HALF * BK * 2  , STAGE_BYTES = 8 * HTB, NXCD = 8, WGM = 8;

__host__ __device__ __forceinline__ int lds_byte(int r, int c) { const int st = (r >> 4) * 2 + (c >> 5), rr = r & 15, cc = c & 31, ob = rr * 64 + cc * 2; return st * 1024 + (ob ^ (((ob >> 9) & 1) << 5)); }
__host__ __device__ __forceinline__ void stage_rc(int b, int& R, int& C) { const int st = b / 1024, sb = b % 1024, swz = sb ^ (((sb >> 9) & 1) << 5); R = (st >> 1) * 16 + swz / 64; C = (st & 1) * 32 + (swz % 64) / 2; }
__host__ __device__ __forceinline__ int perm32(int rho) { const int n = rho >> 4, i = rho & 15; return 8 * (i >> 2) + 4 * n + (i & 3); }

struct Unit { int pm, pn; };
struct Gemm { const bf16_t* A; const bf16_t* Bt; int M, N, K, hB, tB; };

struct StaticOrder {
    int nM, nN, nwg, G, c;
    __host__ __device__ void init(int M, int N, int G_, int c_) { nM = M / BM; nN = N / BM; nwg = nM * nN; G = G_; c = c_; }
    __host__ __device__ bool next(int i, Unit& u) const {
        const long L = (long)i * G + c; if (L >= nwg) return false;
        int wgid = (int)L; { const int q = nwg / NXCD, r = nwg % NXCD, xcd = wgid % NXCD, off = wgid / NXCD; wgid = (xcd < r ? xcd * (q + 1) : r * (q + 1) + (xcd - r) * q) + off; }
        const int nig = WGM * nN, gid = wgid / nig, fm = gid * WGM, gsz = (nM - fm) < WGM ? (nM - fm) : WGM;
        u.pm = fm + ((wgid % nig) % gsz); u.pn = (wgid % nig) / gsz; return true;
    }
    __device__ __forceinline__ void a_ready(const Unit&) const {}
    __device__ __forceinline__ void done(const Unit&) const {}
};

__device__ __forceinline__ unsigned cvt_pk_bf16(float lo, float hi) { unsigned r; asm volatile("v_cvt_pk_bf16_f32 %0, %1, %2" : "=v"(r) : "v"(lo), "v"(hi)); return r; }
typedef unsigned u32x2 __attribute__((ext_vector_type(2)));
constexpr float QSCALE = 0.125f * 1.4426950408889634f;
constexpr int TPROMPT = 65536;
constexpr int RSS_LDS = STAGE_BYTES + 128;

struct EpiInProj {
    static constexpr int BMAP = 2; static constexpr bool AFTER_DRAIN = false;
    bf16_t* P; const unsigned long long* rss; const float* gq; const float* gk; const float* frq; unsigned* kmax;
    __device__ __forceinline__ void pre(PG8_LAS unsigned char*, const Unit&, int, int) const {}
    __device__ __forceinline__ void operator()(const f32x4 (&acc)[2][2][4][2], const Unit& u, int wr, int wc, int fr, int fq, PG8_LAS unsigned char* lds) const {
        const int slot = u.pn * 4 + wc;
        const int type = slot < 8 ? 0 : slot < 10 ? 1 : slot < 12 ? 2 : slot < 20 ? 3 : slot < 28 ? 4 : 2;
        const int colbase = u.pn * 256 + wc * 64 + ((fq & 1) << 4) + ((fq >> 1) << 3);
        f32x4 g[2][2], f4[2];
        if (type <= 1) { const float* gp = type == 0 ? gq : gk;
#pragma unroll
            for (int bj = 0; bj < 2; ++bj)
#pragma unroll
                for (int n = 0; n < 2; ++n) g[bj][n] = *(const f32x4*)(gp + 32 * bj + 16 * n + 4 * fq);
            f4[0] = *(const f32x4*)(frq + 32 + 4 * fq); f4[1] = f4[0]; }
        else if (type >= 3) { f4[0] = *(const f32x4*)(frq + 4 * fq); f4[1] = *(const f32x4*)(frq + 16 + 4 * fq); }
        const int tmask = (u.pm * BM < TPROMPT) ? 2047 : 4095;
        float kmx = 0.f;
#pragma unroll
        for (int ai = 0; ai < 2; ++ai)
#pragma unroll
            for (int m = 0; m < 4; ++m) {
                const int row = u.pm * BM + ai * HALF + wr * 64 + m * 16 + fr; const int t = row & tmask;
                const float rs = __builtin_amdgcn_rsqf((float)rss[row] * (2.3283064365386963e-10f / 1024.0f) + 1e-6f);
                f32x4 v[2][2];
#pragma unroll
                for (int bj = 0; bj < 2; ++bj)
#pragma unroll
                    for (int n = 0; n < 2; ++n) v[bj][n] = acc[ai][bj][m][n] * rs;
                if (type <= 1) {
                    float ss = 0.f;
#pragma unroll
                    for (int bj = 0; bj < 2; ++bj)
#pragma unroll
                        for (int n = 0; n < 2; ++n) { const f32x4 x = v[bj][n]; ss += (x[0] * x[0] + x[1] * x[1]) + (x[2] * x[2] + x[3] * x[3]); }
                    ss += __shfl_xor(ss, 16); ss += __shfl_xor(ss, 32);
                    float rn = __builtin_amdgcn_rsqf(ss * (1.0f / 64.0f) + 1e-6f); if (type == 0) rn *= QSCALE;
#pragma unroll
                    for (int bj = 0; bj < 2; ++bj) { const float pf = (float)(bj == 0 ? (t >> 6) : (t & 63)); f32x4 c, s;
#pragma unroll
                        for (int e = 0; e < 4; ++e) { const float a = __builtin_amdgcn_fractf(pf * f4[0][e]); c[e] = __builtin_amdgcn_cosf(a); s[e] = __builtin_amdgcn_sinf(a); }
                        const f32x4 x1 = v[bj][0] * g[bj][0] * rn, x2 = v[bj][1] * g[bj][1] * rn;
                        v[bj][0] = x1 * c - x2 * s; v[bj][1] = x1 * s + x2 * c; }
                } else if (type >= 3) {
                    const float sc = type == 3 ? QSCALE : 1.0f; const float tf = (float)t;
#pragma unroll
                    for (int n = 0; n < 2; ++n) { f32x4 c, s;
#pragma unroll
                        for (int e = 0; e < 4; ++e) { const float a = __builtin_amdgcn_fractf(tf * f4[n][e]); c[e] = __builtin_amdgcn_cosf(a) * sc; s[e] = __builtin_amdgcn_sinf(a) * sc; }
                        const f32x4 x1 = v[0][n], x2 = v[1][n];
                        v[0][n] = x1 * c - x2 * s; v[1][n] = x1 * s + x2 * c; }
                    if (type == 4) { float ks = 0.f;
#pragma unroll
                        for (int bj = 0; bj < 2; ++bj)
#pragma unroll
                            for (int n = 0; n < 2; ++n) { const f32x4 x = v[bj][n]; ks += (x[0] * x[0] + x[1] * x[1]) + (x[2] * x[2] + x[3] * x[3]); }
                        ks += __shfl_xor(ks, 16); ks += __shfl_xor(ks, 32); kmx = __builtin_fmaxf(kmx, ks); }
                }
                bf16_t* rowp = P + ((size_t)slot * 81920 + row) * 64 + (((fq & 1) << 4) + ((fq >> 1) << 3));
#pragma unroll
                for (int bj = 0; bj < 2; ++bj) {
                    unsigned a0 = cvt_pk_bf16(v[bj][0][0], v[bj][0][1]), a1 = cvt_pk_bf16(v[bj][0][2], v[bj][0][3]), b0 = cvt_pk_bf16(v[bj][1][0], v[bj][1][1]), b1 = cvt_pk_bf16(v[bj][1][2], v[bj][1][3]);
                    { auto r = __builtin_amdgcn_permlane16_swap(a0, b0, false, false); a0 = r[0]; b0 = r[1]; }
                    { auto r = __builtin_amdgcn_permlane16_swap(a1, b1, false, false); a1 = r[0]; b1 = r[1]; }
                    u32x4 w; w.x = a0; w.y = a1; w.z = b0; w.w = b1; *(u32x4*)(rowp + 32 * bj) = w; }
            }
        if (type == 4) {
#pragma unroll
            for (int o = 1; o < 16; o <<= 1) kmx = __builtin_fmaxf(kmx, __shfl_xor(kmx, o));
            const int r0 = u.pm * BM; const int seq = r0 < TPROMPT ? (r0 >> 11) : 32 + ((r0 - TPROMPT) >> 12);
            if (fr == 0 && fq == 0) atomicMax(kmax + seq * 8 + (slot - 20), __float_as_uint(kmx));
        }
    }
};

struct EpiResid {
    static constexpr int BMAP = 0; static constexpr bool AFTER_DRAIN = false;
    bf16_t* xb; unsigned long long* rss_next;
    __device__ __forceinline__ void pre(PG8_LAS unsigned char*, const Unit&, int, int) const {}
    __device__ __forceinline__ void operator()(const f32x4 (&acc)[2][2][4][2], const Unit& u, int wr, int wc, int fr, int fq, PG8_LAS unsigned char*) const {
        const int col0 = u.pn * BM + wc * 32 + 4 * fq;
        u32x2 bs[2][4][2][2];
#pragma unroll
        for (int ai = 0; ai < 2; ++ai)
#pragma unroll
            for (int m = 0; m < 4; ++m) { const size_t off = (size_t)(u.pm * BM + ai * HALF + wr * 64 + m * 16 + fr) * 1024 + col0;
#pragma unroll
                for (int bj = 0; bj < 2; ++bj)
#pragma unroll
                    for (int n = 0; n < 2; ++n) bs[ai][m][bj][n] = *(const u32x2*)(xb + off + bj * HALF + n * 16); }
#pragma unroll
        for (int ai = 0; ai < 2; ++ai)
#pragma unroll
            for (int m = 0; m < 4; ++m) {
                const int row = u.pm * BM + ai * HALF + wr * 64 + m * 16 + fr; float ss = 0.f;
#pragma unroll
                for (int bj = 0; bj < 2; ++bj)
#pragma unroll
                    for (int n = 0; n < 2; ++n) { const u32x2 b = bs[ai][m][bj][n]; const f32x4 a = acc[ai][bj][m][n];
                        const float o0 = __uint_as_float(b.x << 16) + a[0], o1 = __uint_as_float(b.x & 0xffff0000u) + a[1], o2 = __uint_as_float(b.y << 16) + a[2], o3 = __uint_as_float(b.y & 0xffff0000u) + a[3];
                        ss += (o0 * o0 + o1 * o1) + (o2 * o2 + o3 * o3);
                        bs[ai][m][bj][n].x = cvt_pk_bf16(o0, o1); bs[ai][m][bj][n].y = cvt_pk_bf16(o2, o3); }
#pragma unroll
                for (int bj = 0; bj < 2; ++bj) { unsigned a0 = bs[ai][m][bj][0].x, a1 = bs[ai][m][bj][0].y, b0 = bs[ai][m][bj][1].x, b1 = bs[ai][m][bj][1].y;
                    { auto r = __builtin_amdgcn_permlane16_swap(a0, b0, false, false); a0 = r[0]; b0 = r[1]; }
                    { auto r = __builtin_amdgcn_permlane16_swap(a1, b1, false, false); a1 = r[0]; b1 = r[1]; }
                    u32x4 w; w.x = a0; w.y = a1; w.z = b0; w.w = b1; *(u32x4*)(xb + (size_t)row * 1024 + u.pn * BM + wc * 32 + bj * HALF + ((fq & 1) << 4) + ((fq >> 1) << 3)) = w; }
                ss += __shfl_xor(ss, 16); ss += __shfl_xor(ss, 32);
                if (fq == 0) atomicAdd(rss_next + row, (unsigned long long)(ss * 4294967296.0f));
            }
    }
};

struct EpiSwiGLU {
    static constexpr int BMAP = 1; static constexpr bool AFTER_DRAIN = false;
    bf16_t* H; const unsigned long long* rss;
    __device__ __forceinline__ void pre(PG8_LAS unsigned char* lds, const Unit& u, int wid, int tid) const {
        __builtin_amdgcn_global_load_lds((const unsigned*)(rss + (size_t)u.pm * BM) + (unsigned)tid, (PG8_LAS unsigned*)(lds + RSS_LDS + wid * 256), 4, 0, 0);
    }
    __device__ __forceinline__ void operator()(const f32x4 (&acc)[2][2][4][2], const Unit& u, int wr, int wc, int fr, int fq, PG8_LAS unsigned char* lds) const {
        const int col0 = u.pn * 128 + wc * 32 + 8 * fq;
#pragma unroll
        for (int ai = 0; ai < 2; ++ai)
#pragma unroll
            for (int m = 0; m < 4; ++m) {
                const int row = u.pm * BM + ai * HALF + wr * 64 + m * 16 + fr;
                const float rs = __builtin_amdgcn_rsqf((float)*(const PG8_LAS unsigned long long*)(lds + RSS_LDS + (ai * HALF + wr * 64 + m * 16 + fr) * 8) * (2.3283064365386963e-10f / 1024.0f) + 1e-6f);
                const float c1 = -1.4426950408889634f * rs, c2 = rs * rs;
                u32x4 w;
#pragma unroll
                for (int n = 0; n < 2; ++n) { const f32x4 g = acc[ai][0][m][n], uu = acc[ai][1][m][n];
                    const f32x4 t = g * c1; f32x4 ex;
#pragma unroll
                    for (int i = 0; i < 4; ++i) ex[i] = __builtin_amdgcn_exp2f(t[i]);
                    const f32x4 d = ex + 1.0f; f32x4 r;
#pragma unroll
                    for (int i = 0; i < 4; ++i) r[i] = __builtin_amdgcn_rcpf(d[i]);
                    const f32x4 o = ((g * uu) * c2) * r;
                    typedef float f2_t __attribute__((ext_vector_type(2))); typedef __bf16 b2_t __attribute__((ext_vector_type(2)));
                    const f2_t lo = {o[0], o[1]}, hi = {o[2], o[3]};
                    w[2 * n] = __builtin_bit_cast(unsigned, __builtin_convertvector(lo, b2_t)); w[2 * n + 1] = __builtin_bit_cast(unsigned, __builtin_convertvector(hi, b2_t)); }
                __builtin_nontemporal_store(w, (u32x4*)(H + (size_t)row * 2816 + col0));
            }
    }
};

template <class Epi, class Sched, bool ALIGN_EPI = false, bool SP2 = false>
__device__ __forceinline__ void gemm_phase(PG8_LAS unsigned char* lds, const Gemm g, const Sched& S, const Epi& E) {
    int tid_l = threadIdx.x; asm volatile("" : "+v"(tid_l)); const int tid = tid_l, wid = __builtin_amdgcn_readfirstlane(tid >> 6), lane = tid & 63, wr = wid >> 2, wc = wid & 3, fr = lane & 15, fq = lane >> 4;
    const int K = g.K, nt = K / BK;
    unsigned voffA[2], voffB[2];
#pragma unroll
    for (int i = 0; i < 2; ++i) { int R, C; stage_rc(tid * 16 + i * 8192, R, C); const int Rb = Epi::BMAP == 1 ? ((R & ~31) + perm32(R & 31)) : (Epi::BMAP == 2 ? (64 * (R >> 5) + (R & 31)) : R);
        voffA[i] = (unsigned)(R * K + C) * 2u; voffB[i] = (unsigned)(Rb * K + C) * 2u; }
    const size_t kstep = (size_t)(BK * 2);
    const size_t hstep = (size_t)HALF * K * 2;
    const size_t tstep = 2 * hstep; const size_t hstepB = (size_t)g.hB * K * 2, tstepB = (size_t)g.tB * K * 2;
    const unsigned ldsw = (unsigned)wid * 1024u;
    const int aoff = lds_byte(wr * 64 + fr, fq * 8), boff = lds_byte(wc * 32 + fr, fq * 8);
#define PG8_SA(b, h) (((b) * 2 + (h)) * HTB)
#define PG8_SB(b, h) ((4 + (b) * 2 + (h)) * HTB)
#define PG8_STAGE(bufoff, gbase, voff) do { _Pragma("unroll") for (int _i = 0; _i < 2; ++_i) \
        __builtin_amdgcn_global_load_lds((const unsigned*)((const char*)(gbase) + (voff)[_i]), (PG8_LAS unsigned*)(lds + (bufoff) + ldsw + _i * 8192), 16, 0, 0); } while (0)
#define PG8_LDA(dst, b, h) do { _Pragma("unroll") for (int m = 0; m < 4; ++m) _Pragma("unroll") for (int k = 0; k < 2; ++k) dst[m][k] = *(const PG8_LAS bf16x8*)(lds + PG8_SA(b, h) + aoff + m * 2048 + k * 1024); } while (0)
#define PG8_LDB(dst, b, h) do { _Pragma("unroll") for (int n = 0; n < 2; ++n) _Pragma("unroll") for (int k = 0; k < 2; ++k) dst[n][k] = *(const PG8_LAS bf16x8*)(lds + PG8_SB(b, h) + boff + n * 2048 + k * 1024); } while (0)
#define PG8_MMA(ai, bj, At, Bt) do { __builtin_amdgcn_s_setprio(1); _Pragma("unroll") for (int m = 0; m < 4; ++m) _Pragma("unroll") for (int n = 0; n < 2; ++n) _Pragma("unroll") for (int k = 0; k < 2; ++k) \
        acc[ai][bj][m][n] = __builtin_amdgcn_mfma_f32_16x16x32_bf16(Bt[n][k], At[m][k], acc[ai][bj][m][n], 0, 0, 0); __builtin_amdgcn_s_setprio(0); } while (0)
#define PG8_WAIT_V(n) asm volatile("s_waitcnt vmcnt(" #n ")" ::: "memory")
#define PG8_WAIT_L(n) asm volatile("s_waitcnt lgkmcnt(" #n ")" ::: "memory")
#define PG8_BAR __builtin_amdgcn_s_barrier()
#define PG8_SCHED __builtin_amdgcn_sched_barrier(0)
    Unit cur, nxt; int ui = 0;
    if (!S.next(0, cur)) return;
    f32x4 acc[2][2][4][2];
#pragma unroll
    for (int a = 0; a < 2; ++a)
#pragma unroll
        for (int b = 0; b < 2; ++b)
#pragma unroll
            for (int m = 0; m < 4; ++m)
#pragma unroll
                for (int n = 0; n < 2; ++n) acc[a][b][m][n] = (f32x4){0.f, 0.f, 0.f, 0.f};
    bf16x8 At[4][2], B0[2][2], B1[2][2];
    const char* cA = (const char*)g.A + (size_t)cur.pm * tstep; const char* cB = (const char*)g.Bt + (size_t)cur.pn * tstepB;
    S.a_ready(cur);
    if constexpr (SP2) {
        PG8_STAGE(PG8_SB(0, 0), cB, voffB); PG8_STAGE(PG8_SB(0, 1), cB + hstepB, voffB); PG8_STAGE(PG8_SA(0, 0), cA, voffA); PG8_STAGE(PG8_SA(0, 1), cA + hstep, voffA);
        if (wr == 1) PG8_BAR;
        PG8_WAIT_V(2); PG8_BAR;
        PG8_STAGE(PG8_SB(1, 0), cB + kstep, voffB); PG8_STAGE(PG8_SA(1, 0), cA + kstep, voffA); PG8_STAGE(PG8_SB(1, 1), cB + hstepB + kstep, voffB);
        PG8_WAIT_V(6); PG8_BAR;
    } else {
        PG8_STAGE(PG8_SB(0, 0), cB, voffB); PG8_STAGE(PG8_SA(0, 0), cA, voffA); PG8_STAGE(PG8_SB(0, 1), cB + hstepB, voffB); PG8_STAGE(PG8_SA(0, 1), cA + hstep, voffA);
        if (wr == 1) PG8_BAR;
        PG8_WAIT_V(4); PG8_BAR;
        PG8_STAGE(PG8_SB(1, 0), cB + kstep, voffB); PG8_STAGE(PG8_SA(1, 0), cA + kstep, voffA); PG8_STAGE(PG8_SB(1, 1), cB + hstepB + kstep, voffB);
        PG8_WAIT_V(6); PG8_BAR;
    }
    for (;;) {
        const bool has_next = S.next(ui + 1, nxt);
        const char* nA = has_next ? (const char*)g.A + (size_t)nxt.pm * tstep : cA; const char* nB = has_next ? (const char*)g.Bt + (size_t)nxt.pn * tstepB : cB;
        for (int t = 0; t < nt; t += 2) {
            const bool last = (t == nt - 2);
            const char* a1 = cA + (size_t)(t + 1) * kstep;
            const char* a2 = last ? nA : cA + (size_t)(t + 2) * kstep; const char* b2 = last ? nB : cB + (size_t)(t + 2) * kstep;
            const char* a3 = a2 + kstep; const char* b3 = b2 + kstep;
            if (last && has_next) S.a_ready(nxt);
            if (last) E.pre(lds, cur, wid, tid);
            if constexpr (SP2) {
            PG8_LDB(B0, 0, 0); PG8_LDB(B1, 0, 1); PG8_SCHED; PG8_LDA(At, 0, 0); PG8_STAGE(PG8_SA(1, 1), a1 + hstep, voffA);
            PG8_WAIT_V(8); PG8_WAIT_L(0); PG8_BAR; PG8_MMA(0, 0, At, B0); PG8_MMA(0, 1, At, B1); PG8_BAR; PG8_SCHED;
            PG8_LDA(At, 0, 1); PG8_STAGE(PG8_SB(0, 0), b2, voffB); PG8_STAGE(PG8_SB(0, 1), b2 + hstepB, voffB); PG8_STAGE(PG8_SA(0, 0), a2, voffA);
            PG8_WAIT_V(8); PG8_WAIT_L(0); PG8_BAR; PG8_MMA(1, 0, At, B0); PG8_MMA(1, 1, At, B1); PG8_BAR; PG8_SCHED;
            PG8_LDB(B0, 1, 0); PG8_LDB(B1, 1, 1); PG8_SCHED; PG8_LDA(At, 1, 0); PG8_STAGE(PG8_SA(0, 1), a2 + hstep, voffA);
            PG8_WAIT_V(8); PG8_WAIT_L(0); PG8_BAR; PG8_MMA(0, 0, At, B0); PG8_MMA(0, 1, At, B1); PG8_BAR; PG8_SCHED;
            PG8_LDA(At, 1, 1); PG8_STAGE(PG8_SB(1, 0), b3, voffB); PG8_STAGE(PG8_SB(1, 1), b3 + hstepB, voffB); PG8_STAGE(PG8_SA(1, 0), a3, voffA);
            PG8_WAIT_V(8); PG8_WAIT_L(0); PG8_BAR; PG8_MMA(1, 0, At, B0); PG8_MMA(1, 1, At, B1); PG8_BAR; PG8_SCHED;
            } else {
            PG8_LDB(B0, 0, 0); PG8_SCHED; PG8_LDA(At, 0, 0); PG8_STAGE(PG8_SA(1, 1), a1 + hstep, voffA);
            PG8_WAIT_L(8); PG8_BAR; PG8_WAIT_L(0); PG8_MMA(0, 0, At, B0); PG8_BAR; PG8_SCHED;
            PG8_LDB(B1, 0, 1); PG8_STAGE(PG8_SB(0, 0), b2, voffB);
            PG8_BAR; PG8_WAIT_L(0); PG8_MMA(0, 1, At, B1); PG8_BAR;
            PG8_LDA(At, 0, 1); PG8_STAGE(PG8_SA(0, 0), a2, voffA);
            PG8_BAR; PG8_WAIT_L(0); PG8_MMA(1, 0, At, B0); PG8_BAR; PG8_SCHED;
            PG8_STAGE(PG8_SB(0, 1), b2 + hstepB, voffB);
            PG8_WAIT_V(6); PG8_BAR; PG8_MMA(1, 1, At, B1); PG8_BAR;
            PG8_LDB(B0, 1, 0); PG8_SCHED; PG8_LDA(At, 1, 0); PG8_STAGE(PG8_SA(0, 1), a2 + hstep, voffA);
            PG8_WAIT_L(8); PG8_BAR; PG8_WAIT_L(0); PG8_MMA(0, 0, At, B0); PG8_BAR; PG8_SCHED;
            PG8_LDB(B1, 1, 1); PG8_STAGE(PG8_SB(1, 0), b3, voffB);
            PG8_BAR; PG8_WAIT_L(0); PG8_MMA(0, 1, At, B1); PG8_BAR;
            PG8_LDA(At, 1, 1); PG8_STAGE(PG8_SA(1, 0), a3, voffA);
            PG8_BAR; PG8_WAIT_L(0); PG8_MMA(1, 0, At, B0); PG8_BAR; PG8_SCHED;
            PG8_STAGE(PG8_SB(1, 1), b3 + hstepB, voffB);
            PG8_WAIT_V(6); PG8_BAR; PG8_MMA(1, 1, At, B1); PG8_BAR;
            }
        }
        if constexpr (ALIGN_EPI) { if (wr == 0) PG8_BAR; }
        if constexpr (!Epi::AFTER_DRAIN) { E(acc, cur, wr, wc, fr, fq, lds); S.done(cur); }
        if (!has_next) break;
#pragma unroll
        for (int a = 0; a < 2; ++a)
#pragma unroll
            for (int b = 0; b < 2; ++b)
#pragma unroll
                for (int m = 0; m < 4; ++m)
#pragma unroll
                    for (int n = 0; n < 2; ++n) acc[a][b][m][n] = (f32x4){0.f, 0.f, 0.f, 0.f};
        cur = nxt; cA = nA; cB = nB; ++ui;
        if constexpr (ALIGN_EPI) { if (wr == 1) PG8_BAR; }
    }
    PG8_WAIT_V(0);
    if constexpr (!ALIGN_EPI) { if (wr == 0) PG8_BAR; }
    PG8_BAR;
    if constexpr (Epi::AFTER_DRAIN) { E.fused(acc, cur, wr, wc, fr, fq, lds, wid, lane); S.done(cur); }
#undef PG8_SA
#undef PG8_SB
#undef PG8_STAGE
#undef PG8_LDA
#undef PG8_LDB
#undef PG8_MMA
#undef PG8_WAIT_V
#undef PG8_WAIT_L
#undef PG8_BAR
#undef PG8_SCHED
}
}
#include <hip/hip_bf16.h>
#include <cmath>
namespace attn_body {
using bf16=__hip_bfloat16;
using bf16x8=__attribute__((ext_vector_type(8)))short;
using s16x4=__attribute__((ext_vector_type(4)))short;
using f32x16=__attribute__((ext_vector_type(16)))float;
using u32x4=__attribute__((ext_vector_type(4)))unsigned;
constexpr int D=64,DM=64; constexpr long VH1=81920L*64;
constexpr int NW=8,QBLK=32,QB=QBLK*NW,KVBLK=64;
constexpr int ATTN_PITCH=DM, ATTN_UNIT_ROWS=QB;
__device__ __forceinline__ int crow(int r,int hi){return (r&3)+8*(r>>2)+4*hi;}
#define SBAR() __builtin_amdgcn_sched_barrier(0)
__device__ __forceinline__ void cmask(f32x16&p0,f32x16&p1,int jb,int qrel,int hi){
  const float NEG=-INFINITY; int kb=64*jb+4*hi;
  #pragma unroll
  for(int r=0;r<16;++r){int kv=kb+(r&3)+8*(r>>2); if(kv>qrel)p0[r]=NEG; if(kv+32>qrel)p1[r]=NEG;}
}

constexpr int NSLOT=3, SLOTB=8192;
constexpr int LDS_K=0, LDS_V=NSLOT*SLOTB, LDS_WS=2*NSLOT*SLOTB, LDS_OST=LDS_WS+NW*64*4, LDS_BYTES=LDS_OST+NW*4096;
constexpr float C2=0.125f*1.4426950408889634f;
__device__ __forceinline__ void glds16(const void*gsrc,unsigned lds_dst){unsigned keep;
  asm volatile("s_mov_b32 %0, m0\n\ts_mov_b32 m0, %2\n\ts_nop 0\n\tglobal_load_lds_dwordx4 %1, off\n\ts_mov_b32 m0, %0":"=&s"(keep):"v"(gsrc),"s"(lds_dst):"memory");}
__device__ __forceinline__ float max3f(float a,float b,float c){float r;asm("v_max3_f32 %0, %1, %2, %3":"=v"(r):"v"(a),"v"(b),"v"(c));return r;}
__device__ __forceinline__ float max2f(float a,float b){float r;asm("v_max_f32_e32 %0, %1, %2":"=v"(r):"v"(a),"v"(b));return r;}
__device__ __forceinline__ float fadd_s(float a,float b){float r;asm("v_add_f32_e32 %0, %1, %2":"=v"(r):"v"(a),"v"(b));return r;}
__device__ __forceinline__ float fsub_s(float a,float b){float r;asm("v_sub_f32_e32 %0, %1, %2":"=v"(r):"v"(a),"v"(b));return r;}
typedef float f32x2_t __attribute__((ext_vector_type(2))); typedef __bf16 bf16x2_t __attribute__((ext_vector_type(2)));
__device__ __forceinline__ unsigned cvtpk_s(float lo,float hi){f32x2_t v={lo,hi};bf16x2_t b=__builtin_convertvector(v,bf16x2_t);return __builtin_bit_cast(unsigned,b);}
#define WAIT_BAR(N) asm volatile("s_waitcnt vmcnt(" #N ") lgkmcnt(0)\n\ts_barrier":::"memory")

__device__ __forceinline__ void qkt(f32x16&p0,f32x16&p1,const char*Kslot,const bf16x8*qr,const f32x16&negm,int r32,int hi){
  const char*kb=Kslot+(r32>>3)*1024+(((hi^((r32>>3)&1))*8+(r32&7))*16);
  #pragma unroll
  for(int d0=0;d0<4;++d0){
    const bf16x8 b0=*reinterpret_cast<const bf16x8*>(kb+d0*256);
    const bf16x8 b1=*reinterpret_cast<const bf16x8*>(kb+d0*256+4096);
    if(d0==0){p0=__builtin_amdgcn_mfma_f32_32x32x16_bf16(b0,qr[0],negm,0,0,0);p1=__builtin_amdgcn_mfma_f32_32x32x16_bf16(b1,qr[0],negm,0,0,0);}
    else{p0=__builtin_amdgcn_mfma_f32_32x32x16_bf16(b0,qr[d0],p0,0,0,0);p1=__builtin_amdgcn_mfma_f32_32x32x16_bf16(b1,qr[d0],p1,0,0,0);}}
}
typedef __attribute__((address_space(3))) const char* lds_cptr;
typedef short v4i16_t __attribute__((ext_vector_type(4)));
__device__ __forceinline__ void kload8(bf16x8*kf,lds_cptr kp){
  #pragma unroll
  for(int d0=0;d0<4;++d0){ kf[2*d0]=*(const __attribute__((address_space(3))) bf16x8*)(kp+d0*256); kf[2*d0+1]=*(const __attribute__((address_space(3))) bf16x8*)(kp+d0*256+4096); }
}
__device__ __forceinline__ void kload2(bf16x8*kf,lds_cptr kp,int j){ kf[2*j]=*(const __attribute__((address_space(3))) bf16x8*)(kp+j*256); kf[2*j+1]=*(const __attribute__((address_space(3))) bf16x8*)(kp+j*256+4096); }
__device__ __forceinline__ s16x4 vtr(lds_cptr p){ return __builtin_bit_cast(s16x4,__builtin_amdgcn_ds_read_tr16_b64_v4i16((__attribute__((address_space(3))) v4i16_t*)p)); }
__device__ __forceinline__ float rowmax(const f32x16&p0,const f32x16&p1){
  float a=max3f(p0[0],p0[1],p1[0]),b=max3f(p0[2],p0[3],p1[1]);a=max3f(a,p1[2],p1[3]);
  #pragma unroll
  for(int r=4;r<16;r+=4){a=max3f(a,p0[r],p0[r+1]);b=max3f(b,p0[r+2],p0[r+3]);a=max3f(a,p1[r],p1[r+1]);b=max3f(b,p1[r+2],p1[r+3]);}
  const float m=max2f(a,b);
  auto rr=__builtin_amdgcn_permlane32_swap(__float_as_uint(m),__float_as_uint(m),false,false);
  return max2f(__uint_as_float(rr[0]),__uint_as_float(rr[1]));
}
__device__ __forceinline__ void pv(f32x16*o,int vb,bf16x8 pa0,bf16x8 pa1,bf16x8 pa2,bf16x8 pa3){
  #pragma unroll
  for(int d0=0;d0<2;++d0){s16x4 lo[4],hi[4];
    #pragma unroll
    for(int ks=0;ks<4;++ks){
      asm volatile("ds_read_b64_tr_b16 %0,%1 offset:%c2":"=&v"(lo[ks]):"v"(vb),"i"(d0*4096+ks*1024):"memory");
      asm volatile("ds_read_b64_tr_b16 %0,%1 offset:%c2":"=&v"(hi[ks]):"v"(vb),"i"(d0*4096+ks*1024+512):"memory");}
    asm volatile("s_waitcnt lgkmcnt(0)":::"memory");SBAR();
    #define PK(k) (bf16x8){lo[k][0],lo[k][1],lo[k][2],lo[k][3],hi[k][0],hi[k][1],hi[k][2],hi[k][3]}
    o[d0]=__builtin_amdgcn_mfma_f32_32x32x16_bf16(pa0,PK(0),o[d0],0,0,0);
    o[d0]=__builtin_amdgcn_mfma_f32_32x32x16_bf16(pa1,PK(1),o[d0],0,0,0);
    o[d0]=__builtin_amdgcn_mfma_f32_32x32x16_bf16(pa2,PK(2),o[d0],0,0,0);
    o[d0]=__builtin_amdgcn_mfma_f32_32x32x16_bf16(pa3,PK(3),o[d0],0,0,0);
    #undef PK
  }
}

#ifndef ATTN_STORE16
#define ATTN_STORE16(p,v) (*(u32x4*)(p)=(v))
#endif
template<int THRL> __device__ __forceinline__ void attn_unit(const bf16*Qp,const bf16*__restrict__ Kp,const bf16*__restrict__ Vp,bf16*Op,int opitch,int NT,char*shm,float mfix){
  int tid_l=threadIdx.x; asm volatile("":"+v"(tid_l)); const int tid=tid_l,lane=tid&63,r32=lane&31,hi=lane>>5; const int wid=__builtin_amdgcn_readfirstlane(tid>>6);
  const bf16*Qw=Qp+(long)(wid*QBLK)*DM;
  const bf16*Kh=Kp,*Vh=Vp;
  const unsigned lds0=(unsigned)(uintptr_t)shm;
  float*wsf=(float*)(shm+LDS_WS)+wid*64;
  const bf16*ksrc=Kh+(long)(8*wid+(lane&7))*DM+((lane>>3)^(wid&1))*8;
  const bf16*vsrc=Vh+(long)(16*(wid&3)+(lane>>2))*DM+(wid>>2)*32+(lane&3)*8;
  const unsigned kdst=lds0+LDS_K+wid*1024, vdst=lds0+LDS_V+wid*1024;
  #define DMA_K(t,slot) glds16(ksrc+(long)(t)*KVBLK*DM,(unsigned)__builtin_amdgcn_readfirstlane(kdst+(slot)))
  #define DMA_V(t,slot) glds16(vsrc+(long)(t)*KVBLK*DM,(unsigned)__builtin_amdgcn_readfirstlane(vdst+(slot)))
  const int vb0=(int)(lds0+LDS_V)+((lane>>4)&1)*32+(lane&3)*8+(4*hi+((lane&15)>>2))*64;
  const char*Kbase=shm+LDS_K; bf16x8 kf[8];
  const lds_cptr shm3=(lds_cptr)shm; const lds_cptr kp0=shm3+LDS_K+(r32>>3)*1024+(((hi^((r32>>3)&1))*8+(r32&7))*16); const lds_cptr vp0=shm3+LDS_V+((lane>>4)&1)*32+(lane&3)*8+(4*hi+((lane&15)>>2))*64;
  DMA_K(0,0);DMA_V(0,0);DMA_K(1,SLOTB);
  bf16x8 qr[4];
  #pragma unroll
  for(int d0=0;d0<4;++d0)qr[d0]=*reinterpret_cast<const bf16x8*>(&Qw[(long)r32*DM+d0*16+hi*8]);
  float mhat=0.f,l_reg=0.f;f32x16 o[2];o[0]=f32x16{};o[1]=f32x16{};float mfl=mfix; asm volatile("":"+v"(mfl)); f32x16 negm; _Pragma("unroll") for(int r=0;r<16;++r)negm[r]=-mfl; asm volatile("":"+v"(negm)); mhat=mfl;
  const int qrel=wid*QBLK+r32;
  #define CMASK(P0,P1,t) do{}while(0)
  bool resc=false;
  #define START(P0,P1) do{ resc=false; _Pragma("unroll") for(int r=0;r<16;++r)P0[r]=__builtin_amdgcn_exp2f(P0[r]); }while(0)
  #define RESC() do{ if(resc){ asm volatile("s_waitcnt lgkmcnt(0)":::"memory"); \
      _Pragma("unroll") for(int d_=0;d_<2;++d_) _Pragma("unroll") for(int r=0;r<16;++r)o[d_][r]*=wsf[crow(r,hi)]; } }while(0)
  f32x16 pA0,pA1,pB0,pB1;
  int sl_prev=0,sl_cur=0,sl_next=SLOTB;
  #define ROT() do{sl_prev=sl_cur;sl_cur=sl_next;sl_next=(sl_next==(NSLOT-1)*SLOTB)?0:sl_next+SLOTB;}while(0)
  DMA_K(2,2*SLOTB);
  WAIT_BAR(3);
  qkt(pA0,pA1,Kbase,qr,negm,r32,hi);asm volatile("s_nop 15\n\ts_nop 7":"+v"(pA0),"+v"(pA1));CMASK(pA0,pA1,0);
  START(pA0,pA1);
  _Pragma("unroll") for(int r=0;r<16;++r)pA1[r]=__builtin_amdgcn_exp2f(pA1[r]);
  WAIT_BAR(0);
  DMA_K(3,0);DMA_V(1,SLOTB);
  ROT();
  kload8(kf,kp0+sl_cur);
  WAIT_BAR(2);
  s16x4 vlo[8],vhi[8]; u32x4 pw0,pw1,pw2,pw3;
  #define PKW(P,B) cvtpk_s(P[B],P[B+1])
  #define PAF(k) __builtin_bit_cast(bf16x8,pw##k)
  #define VFR(i) (bf16x8){vlo[i][0],vlo[i][1],vlo[i][2],vlo[i][3],vhi[i][0],vhi[i][1],vhi[i][2],vhi[i][3]}
  #define PIN(x) asm volatile("":"+v"(x))
  #define MX3(a,b,c) __builtin_fmaxf(__builtin_fmaxf((a),(b)),(c))
  #define GAPA(MF,A0,A1,A2,A3,W0,W1,PW) do{ MF; sacc+=A0; sacc+=A1; sacc+=A2; sacc+=A3; PIN(sacc); W0; W1; PIN(PW); SBAR(); }while(0)
  #define EX(v) __builtin_amdgcn_exp2f(v)
  #define GAPB(MF,X,B) do{ MF; X[B]=EX(X[B]); X[B+1]=EX(X[B+1]); X[B+2]=EX(X[B+2]); X[B+3]=EX(X[B+3]); PIN(X); SBAR(); }while(0)
  #define VRD(i) do{ vlo[i]=vtr(vp_+(((i)>>2)*4096+((i)&3)*1024)); vhi[i]=vtr(vp_+(((i)>>2)*4096+((i)&3)*1024+512)); }while(0)
  #define KRD(G,j) do{ if(G){ kload2(kf,kp0+sl_next,j); SBAR(); } }while(0)
  #define STEP(C0,C1,P0,P1,t,GK,GV,GL) do{ SBAR(); \
    const lds_cptr vp_=vp0+sl_prev; \
    VRD(0); SBAR(); float sacc=(P0[0]+P0[1]); \
    GAPA(C0=__builtin_amdgcn_mfma_f32_32x32x16_bf16(kf[0],qr[0],negm,0,0,0), P0[2],P0[3],P0[4],P0[5],     pw0[0]=PKW(P0,0), pw0[1]=PKW(P0,2), pw0); \
    VRD(4); SBAR(); GAPA(C1=__builtin_amdgcn_mfma_f32_32x32x16_bf16(kf[1],qr[0],negm,0,0,0), P0[6],P0[7],P0[8],P0[9],     pw0[2]=PKW(P0,4), pw0[3]=PKW(P0,6), pw0); \
    VRD(1); SBAR(); GAPA(C0=__builtin_amdgcn_mfma_f32_32x32x16_bf16(kf[2],qr[1],C0,0,0,0),   P0[10],P0[11],P0[12],P0[13], pw1[0]=PKW(P0,8), pw1[1]=PKW(P0,10), pw1); \
    VRD(5); SBAR(); GAPA(C1=__builtin_amdgcn_mfma_f32_32x32x16_bf16(kf[3],qr[1],C1,0,0,0),   P0[14],P0[15],P1[0],P1[1],   pw1[2]=PKW(P0,12),pw1[3]=PKW(P0,14), pw1); \
    VRD(2); SBAR(); GAPA(C0=__builtin_amdgcn_mfma_f32_32x32x16_bf16(kf[4],qr[2],C0,0,0,0),   P1[2],P1[3],P1[4],P1[5],     pw2[0]=PKW(P1,0), pw2[1]=PKW(P1,2), pw2); \
    VRD(6); SBAR(); GAPA(C1=__builtin_amdgcn_mfma_f32_32x32x16_bf16(kf[5],qr[2],C1,0,0,0),   P1[6],P1[7],P1[8],P1[9],     pw2[2]=PKW(P1,4), pw2[3]=PKW(P1,6), pw2); \
    VRD(3); SBAR(); GAPA(C0=__builtin_amdgcn_mfma_f32_32x32x16_bf16(kf[6],qr[3],C0,0,0,0),   P1[10],P1[11],P1[12],P1[13], pw3[0]=PKW(P1,8), pw3[1]=PKW(P1,10), pw3); \
    VRD(7); SBAR(); GAPA(C1=__builtin_amdgcn_mfma_f32_32x32x16_bf16(kf[7],qr[3],C1,0,0,0),   P1[14],P1[15],0.f,0.f,       pw3[2]=PKW(P1,12),pw3[3]=PKW(P1,14), pw3); \
    l_reg+=sacc; \
    if(GK){DMA_K((t)+3,sl_cur);} if(GV){DMA_V((t)+1,sl_next);} \
    CMASK(C0,C1,t); \
    SBAR(); \
    GAPB(o[0]=__builtin_amdgcn_mfma_f32_32x32x16_bf16(PAF(0),VFR(0),o[0],0,0,0), C0,0); \
    GAPB(o[1]=__builtin_amdgcn_mfma_f32_32x32x16_bf16(PAF(0),VFR(4),o[1],0,0,0), C0,4); \
    KRD(GL,0); GAPB(o[0]=__builtin_amdgcn_mfma_f32_32x32x16_bf16(PAF(1),VFR(1),o[0],0,0,0), C0,8); \
    KRD(GL,1); GAPB(o[1]=__builtin_amdgcn_mfma_f32_32x32x16_bf16(PAF(1),VFR(5),o[1],0,0,0), C0,12); \
    KRD(GL,2); GAPB(o[0]=__builtin_amdgcn_mfma_f32_32x32x16_bf16(PAF(2),VFR(2),o[0],0,0,0), C1,0); \
    KRD(GL,3); GAPB(o[1]=__builtin_amdgcn_mfma_f32_32x32x16_bf16(PAF(2),VFR(6),o[1],0,0,0), C1,4); \
    GAPB(o[0]=__builtin_amdgcn_mfma_f32_32x32x16_bf16(PAF(3),VFR(3),o[0],0,0,0), C1,8); \
    GAPB(o[1]=__builtin_amdgcn_mfma_f32_32x32x16_bf16(PAF(3),VFR(7),o[1],0,0,0), C1,12); \
    }while(0)
  int t=1;
  #undef CMASK
  #define CMASK(P0,P1,t) do{}while(0)
  for(;t+5<NT;t+=2){
    STEP(pB0,pB1,pA0,pA1,t,true,true,true);     WAIT_BAR(2); RESC(); ROT();
    STEP(pA0,pA1,pB0,pB1,t+1,true,true,true);   WAIT_BAR(2); RESC(); ROT();
  }
  #undef CMASK
  #define CMASK(P0,P1,t) do{}while(0)
  #define ENDW(tt) do{ if((tt)+3<NT){WAIT_BAR(2);} else if((tt)+2<NT){WAIT_BAR(1);} else {WAIT_BAR(0);} }while(0)
  for(;t+1<NT;t+=2){
    STEP(pB0,pB1,pA0,pA1,t,(t+3<NT),(t+1<NT),(t+1<NT));       ENDW(t);   RESC(); ROT();
    STEP(pA0,pA1,pB0,pB1,t+1,(t+4<NT),(t+2<NT),(t+2<NT));     ENDW(t+1); RESC(); ROT();
  }
  STEP(pB0,pB1,pA0,pA1,NT-1,false,false,false); RESC();
  { float sacc=pB0[0]+pB0[1]; _Pragma("unroll") for(int r=2;r<16;++r)sacc+=pB0[r]; _Pragma("unroll") for(int r=0;r<16;++r)sacc+=pB1[r]; l_reg+=sacc;
    pw0=(u32x4){PKW(pB0,0),PKW(pB0,2),PKW(pB0,4),PKW(pB0,6)};pw1=(u32x4){PKW(pB0,8),PKW(pB0,10),PKW(pB0,12),PKW(pB0,14)};pw2=(u32x4){PKW(pB1,0),PKW(pB1,2),PKW(pB1,4),PKW(pB1,6)};pw3=(u32x4){PKW(pB1,8),PKW(pB1,10),PKW(pB1,12),PKW(pB1,14)};
    SBAR(); pv(o,vb0+sl_cur,PAF(0),PAF(1),PAF(2),PAF(3)); }
  #undef PKW
  #undef PAF
  #undef VFR
  #undef PIN
  #undef MX3
  #undef GAPA
  #undef GAPB
  #undef EX
  #undef VRD
  #undef KRD
  #undef STEP
  #undef ENDW
  {auto rr=__builtin_amdgcn_permlane32_swap(__float_as_uint(l_reg),__float_as_uint(l_reg),false,false);l_reg=__uint_as_float(rr[0])+__uint_as_float(rr[1]);}
  if(hi==0)wsf[32+r32]=l_reg;asm volatile("s_waitcnt lgkmcnt(0)":::"memory");
  float rli[16];
  #pragma unroll
  for(int r=0;r<16;++r)rli[r]=__builtin_amdgcn_rcpf(wsf[32+crow(r,hi)]);
  bf16*Ow=Op+(long)(wid*QBLK)*opitch;
  { bf16*stg=(bf16*)(shm+LDS_OST)+wid*2048;
    #pragma unroll
    for(int r=0;r<16;++r){const int orow=crow(r,hi);
      #pragma unroll
      for(int d0=0;d0<2;++d0)stg[orow*64+d0*32+r32]=__float2bfloat16(o[d0][r]*rli[r]);}
    asm volatile("s_waitcnt lgkmcnt(0)":::"memory");
    #pragma unroll
    for(int i=0;i<4;++i){const int row=i*8+(lane>>3),ch=lane&7; const u32x4 v=*(const u32x4*)(stg+row*64+ch*8); ATTN_STORE16(Ow+(long)row*opitch+ch*8,v);} }
  asm volatile("s_waitcnt lgkmcnt(0)\n\ts_barrier":::"memory");
  #undef DMA_K
  #undef DMA_V
  #undef CMASK
  #undef START
  #undef RESC
  #undef ROT
}
template<int THRL> __device__ __forceinline__ void attn_unit2(const bf16*Qp,const bf16*__restrict__ Kp,const bf16*__restrict__ Vp,bf16*Op,int opitch,int NT,char*shm,float kmax2){
  int tid_l=threadIdx.x; asm volatile("":"+v"(tid_l)); const int tid=tid_l,lane=tid&63,r32=lane&31,hi=lane>>5; const int wid=__builtin_amdgcn_readfirstlane(tid>>6);
  constexpr int L2_V=NSLOT*SLOTB, L2_WS=L2_V+NSLOT*2*SLOTB, L2_OST=L2_WS+NW*64*4;
  const bf16*Qw=Qp+(long)(wid*QBLK)*DM;
  const bf16*Kh=Kp,*Vh=Vp;
  const unsigned lds0=(unsigned)(uintptr_t)shm;
  float*wsf=(float*)(shm+L2_WS)+wid*64;
  const bf16*ksrc=Kh+(long)(8*wid+(lane&7))*DM+((lane>>3)^(wid&1))*8;
  const bf16*vsrc=Vh+(long)(16*(wid&3)+(lane>>2))*DM+(wid>>2)*32+(lane&3)*8;
  const unsigned kdst=lds0+LDS_K+wid*1024, vdst=lds0+L2_V+wid*1024;
  #define DMA_K(t,slot) glds16(ksrc+(long)(t)*KVBLK*DM,(unsigned)__builtin_amdgcn_readfirstlane(kdst+(slot)))
  #define DMA_V(t,slot) do{ glds16(vsrc+(long)(t)*KVBLK*DM,(unsigned)__builtin_amdgcn_readfirstlane(vdst+2*(slot))); glds16(vsrc+VH1+(long)(t)*KVBLK*DM,(unsigned)__builtin_amdgcn_readfirstlane(vdst+2*(slot)+8192)); }while(0)
  const int vb0=(int)(lds0+L2_V)+((lane>>4)&1)*32+(lane&3)*8+(4*hi+((lane&15)>>2))*64;
  const char*Kbase=shm+LDS_K; bf16x8 kf[8];
  const lds_cptr shm3=(lds_cptr)shm; const lds_cptr kp0=shm3+LDS_K+(r32>>3)*1024+(((hi^((r32>>3)&1))*8+(r32&7))*16); const lds_cptr vp0=shm3+L2_V+((lane>>4)&1)*32+(lane&3)*8+(4*hi+((lane&15)>>2))*64;
  DMA_K(0,0);DMA_V(0,0);DMA_K(1,SLOTB);
  bf16x8 qr[4];
  #pragma unroll
  for(int d0=0;d0<4;++d0)qr[d0]=*reinterpret_cast<const bf16x8*>(&Qw[(long)r32*DM+d0*16+hi*8]);
  float mhat=0.f,l_reg=0.f;f32x16 o[4];o[0]=f32x16{};o[1]=f32x16{};o[2]=f32x16{};o[3]=f32x16{};f32x16 negm=f32x16{};asm volatile("":"+v"(negm));
  const int qrel=wid*QBLK+r32;
  #define CMASK(P0,P1,t) do{}while(0)
  bool resc=false;
  #define START(P0,P1) do{ resc=false; _Pragma("unroll") for(int r=0;r<16;++r)P0[r]=__builtin_amdgcn_exp2f(P0[r]); }while(0)
  #define RESC() do{ if(resc){ asm volatile("s_waitcnt lgkmcnt(0)":::"memory"); \
      _Pragma("unroll") for(int d_=0;d_<4;++d_) _Pragma("unroll") for(int r=0;r<16;++r)o[d_][r]*=wsf[crow(r,hi)]; } }while(0)
  f32x16 pA0,pA1,pB0,pB1;
  int sl_prev=0,sl_cur=0,sl_next=SLOTB;
  #define ROT() do{sl_prev=sl_cur;sl_cur=sl_next;sl_next=(sl_next==(NSLOT-1)*SLOTB)?0:sl_next+SLOTB;}while(0)
  DMA_K(2,2*SLOTB);
  { float q2=0.f;
    _Pragma("unroll") for(int d0=0;d0<4;++d0) _Pragma("unroll") for(int e=0;e<8;++e){ const float v=__uint_as_float(((unsigned)(unsigned short)qr[d0][e])<<16); q2+=v*v; }
    auto rr=__builtin_amdgcn_permlane32_swap(__float_as_uint(q2),__float_as_uint(q2),false,false); q2=__uint_as_float(rr[0])+__uint_as_float(rr[1]);
    float kl=kmax2; asm volatile("":"+v"(kl));
    const float mfl=__builtin_amdgcn_sqrtf(q2*kl)*1.02f; mhat=mfl;
    _Pragma("unroll") for(int r=0;r<16;++r)negm[r]=-mfl; asm volatile("":"+v"(negm)); }
  WAIT_BAR(4);
  qkt(pA0,pA1,Kbase,qr,negm,r32,hi);asm volatile("s_nop 15\n\ts_nop 7":"+v"(pA0),"+v"(pA1));CMASK(pA0,pA1,0);
  START(pA0,pA1);
  _Pragma("unroll") for(int r=0;r<16;++r)pA1[r]=__builtin_amdgcn_exp2f(pA1[r]);
  WAIT_BAR(0);
  DMA_K(3,0);DMA_V(1,SLOTB);
  ROT();
  kload8(kf,kp0+sl_cur);
  WAIT_BAR(3);
  s16x4 vlo[8],vhi[8]; u32x4 pw0,pw1,pw2,pw3;
  #define PKW(P,B) cvtpk_s(P[B],P[B+1])
  #define PAF(k) __builtin_bit_cast(bf16x8,pw##k)
  #define VFR(i) (bf16x8){vlo[i][0],vlo[i][1],vlo[i][2],vlo[i][3],vhi[i][0],vhi[i][1],vhi[i][2],vhi[i][3]}
  #define PIN(x) asm volatile("":"+v"(x))
  #define MX3(a,b,c) __builtin_fmaxf(__builtin_fmaxf((a),(b)),(c))
  #define GAPA(MF,A0,A1,A2,A3,W0,W1,PW) do{ MF; sacc+=A0; sacc+=A1; sacc+=A2; sacc+=A3; PIN(sacc); W0; W1; PIN(PW); SBAR(); }while(0)
  #define EX(v) __builtin_amdgcn_exp2f(v)
  #define GAPB(MF,X,B) do{ MF; X[B]=EX(X[B]); X[B+1]=EX(X[B+1]); PIN(X); SBAR(); }while(0)
  #define VRD2(i) do{ vlo[i]=vtr(vp_+8192+(((i)>>2)*4096+((i)&3)*1024)); vhi[i]=vtr(vp_+8192+(((i)>>2)*4096+((i)&3)*1024+512)); SBAR(); }while(0)
  #define VRD(i) do{ vlo[i]=vtr(vp_+(((i)>>2)*4096+((i)&3)*1024)); vhi[i]=vtr(vp_+(((i)>>2)*4096+((i)&3)*1024+512)); }while(0)
  #define KRD(G,j) do{ if(G){ kload2(kf,kp0+sl_next,j); SBAR(); } }while(0)
  #define STEP(C0,C1,P0,P1,t,GK,GV,GL) do{ SBAR(); \
    const lds_cptr vp_=vp0+2*sl_prev; \
    VRD(0); SBAR(); float sacc=(P0[0]+P0[1]); \
    GAPA(C0=__builtin_amdgcn_mfma_f32_32x32x16_bf16(kf[0],qr[0],negm,0,0,0), P0[2],P0[3],P0[4],P0[5],     pw0[0]=PKW(P0,0), pw0[1]=PKW(P0,2), pw0); \
    VRD(4); SBAR(); GAPA(C1=__builtin_amdgcn_mfma_f32_32x32x16_bf16(kf[1],qr[0],negm,0,0,0), P0[6],P0[7],P0[8],P0[9],     pw0[2]=PKW(P0,4), pw0[3]=PKW(P0,6), pw0); \
    VRD(1); SBAR(); GAPA(C0=__builtin_amdgcn_mfma_f32_32x32x16_bf16(kf[2],qr[1],C0,0,0,0),   P0[10],P0[11],P0[12],P0[13], pw1[0]=PKW(P0,8), pw1[1]=PKW(P0,10), pw1); \
    VRD(5); SBAR(); GAPA(C1=__builtin_amdgcn_mfma_f32_32x32x16_bf16(kf[3],qr[1],C1,0,0,0),   P0[14],P0[15],P1[0],P1[1],   pw1[2]=PKW(P0,12),pw1[3]=PKW(P0,14), pw1); \
    VRD(2); SBAR(); GAPA(C0=__builtin_amdgcn_mfma_f32_32x32x16_bf16(kf[4],qr[2],C0,0,0,0),   P1[2],P1[3],P1[4],P1[5],     pw2[0]=PKW(P1,0), pw2[1]=PKW(P1,2), pw2); \
    VRD(6); SBAR(); GAPA(C1=__builtin_amdgcn_mfma_f32_32x32x16_bf16(kf[5],qr[2],C1,0,0,0),   P1[6],P1[7],P1[8],P1[9],     pw2[2]=PKW(P1,4), pw2[3]=PKW(P1,6), pw2); \
    VRD(3); SBAR(); GAPA(C0=__builtin_amdgcn_mfma_f32_32x32x16_bf16(kf[6],qr[3],C0,0,0,0),   P1[10],P1[11],P1[12],P1[13], pw3[0]=PKW(P1,8), pw3[1]=PKW(P1,10), pw3); \
    VRD(7); SBAR(); GAPA(C1=__builtin_amdgcn_mfma_f32_32x32x16_bf16(kf[7],qr[3],C1,0,0,0),   P1[14],P1[15],0.f,0.f,       pw3[2]=PKW(P1,12),pw3[3]=PKW(P1,14), pw3); \
    l_reg+=sacc; \
    if(GK){DMA_K((t)+3,sl_cur);} if(GV){DMA_V((t)+1,sl_next);} \
    CMASK(C0,C1,t); \
    SBAR(); \
    GAPB(o[0]=__builtin_amdgcn_mfma_f32_32x32x16_bf16(PAF(0),VFR(0),o[0],0,0,0), C0,0); VRD2(0); \
    GAPB(o[1]=__builtin_amdgcn_mfma_f32_32x32x16_bf16(PAF(0),VFR(4),o[1],0,0,0), C0,2); VRD2(4); \
    GAPB(o[0]=__builtin_amdgcn_mfma_f32_32x32x16_bf16(PAF(1),VFR(1),o[0],0,0,0), C0,4); VRD2(1); \
    GAPB(o[1]=__builtin_amdgcn_mfma_f32_32x32x16_bf16(PAF(1),VFR(5),o[1],0,0,0), C0,6); VRD2(5); \
    GAPB(o[0]=__builtin_amdgcn_mfma_f32_32x32x16_bf16(PAF(2),VFR(2),o[0],0,0,0), C0,8); VRD2(2); \
    GAPB(o[1]=__builtin_amdgcn_mfma_f32_32x32x16_bf16(PAF(2),VFR(6),o[1],0,0,0), C0,10); VRD2(6); \
    GAPB(o[0]=__builtin_amdgcn_mfma_f32_32x32x16_bf16(PAF(3),VFR(3),o[0],0,0,0), C0,12); VRD2(3); \
    GAPB(o[1]=__builtin_amdgcn_mfma_f32_32x32x16_bf16(PAF(3),VFR(7),o[1],0,0,0), C0,14); VRD2(7); \
    GAPB(o[2]=__builtin_amdgcn_mfma_f32_32x32x16_bf16(PAF(0),VFR(0),o[2],0,0,0), C1,0); \
    GAPB(o[3]=__builtin_amdgcn_mfma_f32_32x32x16_bf16(PAF(0),VFR(4),o[3],0,0,0), C1,2); \
    KRD(GL,0); GAPB(o[2]=__builtin_amdgcn_mfma_f32_32x32x16_bf16(PAF(1),VFR(1),o[2],0,0,0), C1,4); \
    KRD(GL,1); GAPB(o[3]=__builtin_amdgcn_mfma_f32_32x32x16_bf16(PAF(1),VFR(5),o[3],0,0,0), C1,6); \
    KRD(GL,2); GAPB(o[2]=__builtin_amdgcn_mfma_f32_32x32x16_bf16(PAF(2),VFR(2),o[2],0,0,0), C1,8); \
    KRD(GL,3); GAPB(o[3]=__builtin_amdgcn_mfma_f32_32x32x16_bf16(PAF(2),VFR(6),o[3],0,0,0), C1,10); \
    GAPB(o[2]=__builtin_amdgcn_mfma_f32_32x32x16_bf16(PAF(3),VFR(3),o[2],0,0,0), C1,12); \
    GAPB(o[3]=__builtin_amdgcn_mfma_f32_32x32x16_bf16(PAF(3),VFR(7),o[3],0,0,0), C1,14); \
    }while(0)
  int t=1;
  #undef CMASK
  #define CMASK(P0,P1,t) do{}while(0)
  for(;t+5<NT;t+=2){
    STEP(pB0,pB1,pA0,pA1,t,true,true,true);     WAIT_BAR(3); RESC(); ROT();
    STEP(pA0,pA1,pB0,pB1,t+1,true,true,true);   WAIT_BAR(3); RESC(); ROT();
  }
  #undef CMASK
  #define CMASK(P0,P1,t) do{}while(0)
  #define ENDW(tt) do{ if((tt)+3<NT){WAIT_BAR(3);} else if((tt)+2<NT){WAIT_BAR(2);} else {WAIT_BAR(0);} }while(0)
  for(;t+1<NT;t+=2){
    STEP(pB0,pB1,pA0,pA1,t,(t+3<NT),(t+1<NT),(t+1<NT));       ENDW(t);   RESC(); ROT();
    STEP(pA0,pA1,pB0,pB1,t+1,(t+4<NT),(t+2<NT),(t+2<NT));     ENDW(t+1); RESC(); ROT();
  }
  STEP(pB0,pB1,pA0,pA1,NT-1,false,false,false); RESC();
  { float sacc=pB0[0]+pB0[1]; _Pragma("unroll") for(int r=2;r<16;++r)sacc+=pB0[r]; _Pragma("unroll") for(int r=0;r<16;++r)sacc+=pB1[r]; l_reg+=sacc;
    pw0=(u32x4){PKW(pB0,0),PKW(pB0,2),PKW(pB0,4),PKW(pB0,6)};pw1=(u32x4){PKW(pB0,8),PKW(pB0,10),PKW(pB0,12),PKW(pB0,14)};pw2=(u32x4){PKW(pB1,0),PKW(pB1,2),PKW(pB1,4),PKW(pB1,6)};pw3=(u32x4){PKW(pB1,8),PKW(pB1,10),PKW(pB1,12),PKW(pB1,14)};
    SBAR(); pv(o,vb0+2*sl_cur,PAF(0),PAF(1),PAF(2),PAF(3)); pv(o+2,vb0+2*sl_cur+8192,PAF(0),PAF(1),PAF(2),PAF(3)); }
  #undef PKW
  #undef PAF
  #undef VFR
  #undef PIN
  #undef MX3
  #undef GAPA
  #undef GAPB
  #undef EX
  #undef VRD2
  #undef negm
  #undef VRD
  #undef KRD
  #undef STEP
  #undef ENDW
  {auto rr=__builtin_amdgcn_permlane32_swap(__float_as_uint(l_reg),__float_as_uint(l_reg),false,false);l_reg=__uint_as_float(rr[0])+__uint_as_float(rr[1]);}
  if(hi==0)wsf[32+r32]=l_reg;asm volatile("s_waitcnt lgkmcnt(0)":::"memory");
  float rli[16];
  #pragma unroll
  for(int r=0;r<16;++r)rli[r]=__builtin_amdgcn_rcpf(wsf[32+crow(r,hi)]);
  bf16*Ow=Op+(long)(wid*QBLK)*opitch;
  { bf16*stg=(bf16*)(shm+L2_OST)+wid*2048;
    #pragma unroll
    for(int hh=0;hh<2;++hh){
    #pragma unroll
    for(int r=0;r<16;++r){const int orow=crow(r,hi);
      #pragma unroll
      for(int d0=0;d0<2;++d0)stg[orow*64+d0*32+r32]=__float2bfloat16(o[2*hh+d0][r]*rli[r]);}
    asm volatile("s_waitcnt lgkmcnt(0)":::"memory");
    #pragma unroll
    for(int i=0;i<4;++i){const int row=i*8+(lane>>3),ch=lane&7; const u32x4 v=*(const u32x4*)(stg+row*64+ch*8); ATTN_STORE16(Ow+(long)row*opitch+hh*64+ch*8,v);}
    asm volatile("s_waitcnt lgkmcnt(0)":::"memory"); } }
  asm volatile("s_waitcnt lgkmcnt(0)\n\ts_barrier":::"memory");
  #undef DMA_K
  #undef DMA_V
  #undef CMASK
  #undef START
  #undef RESC
  #undef ROT
}
constexpr int ATTN_LDS_BYTES=LDS_BYTES;
#undef SBAR
#undef WAIT_BAR
}

namespace cg = cooperative_groups;
#define LAS __attribute__((address_space(3)))
typedef unsigned short bf16;
typedef unsigned v4u __attribute__((ext_vector_type(4)));
typedef unsigned v2u __attribute__((ext_vector_type(2)));
typedef float f32x4 __attribute__((ext_vector_type(4)));
constexpr int NWAVES = 8;
constexpr int DM = 1024, TP = 65536, TS = 16384, T = TP + TS, INW = 2304, DFF = 2816;
constexpr size_t MiB = 1u << 20;
constexpr size_t WS_TABA = 0, WS_TABT = 64 * 1024, WS_RSS = 764 * MiB, WS_W = 4 * MiB, W_LAYER = 23 * MiB;
constexpr size_t WO_IN = 0, WO_OUT = (size_t)(4.5 * 1048576), WO_GU = (size_t)(6.5 * 1048576), WO_DN = (size_t)(17.5 * 1048576);
constexpr size_t WS_SCR = 52 * MiB, WS_XB = 84 * MiB, WS_PROJ = 244 * MiB, WS_MIX = 604 * MiB, WS_H = 244 * MiB, WS_END = 768 * MiB;
static_assert(WS_RSS + 5 * (size_t)T * 8 <= WS_END && WS_W + 2 * W_LAYER <= WS_SCR && WS_XB + (size_t)T * DM * 2 <= WS_PROJ && WS_PROJ + (size_t)T * INW * 2 <= WS_MIX && WS_H + (size_t)T * DFF * 2 <= WS_RSS, "ws map");
constexpr int LDS_BYTES = 147456;
constexpr int NPHASE = 12;
constexpr size_t WS_BAR = 1 * MiB;
constexpr size_t WS_KMAX = 512 * 1024;
constexpr int LDS_MISC = 131072 + 64;

__device__ __forceinline__ unsigned f2bf(float f) { unsigned u = __builtin_bit_cast(unsigned, f); return (u + 0x7fffu + ((u >> 16) & 1u)) >> 16; }
__device__ __forceinline__ unsigned pk2(float lo, float hi) { return f2bf(lo) | (f2bf(hi) << 16); }
__device__ __forceinline__ float wave_sum(float v) {
#pragma unroll
    for (int o = 1; o < 64; o <<= 1) v += __shfl_xor(v, o);
    return v;
}
__device__ __forceinline__ void p0_transpose_item(const float* W, const float* gain, int K, int N, bf16* WT, LAS float* scr, int item, int lane) {
    const int nblk = N / 32, kb = item / nblk, nb = item % nblk, k0 = 64 * kb, n0 = 32 * nb;
    float wv[32];
#pragma unroll
    for (int i = 0; i < 32; ++i) { const int kk = 2 * i + (lane >> 5); wv[i] = W[(size_t)(k0 + kk) * N + n0 + (lane & 31)]; }
#pragma unroll
    for (int i = 0; i < 32; ++i) { const int kk = 2 * i + (lane >> 5); const float gv = gain ? gain[k0 + kk] : 1.0f; scr[kk * 33 + (lane & 31)] = wv[i] * gv; }
    asm volatile("s_waitcnt lgkmcnt(0)" ::: "memory");
    const int c = lane & 7;
#pragma unroll
    for (int j = 0; j < 4; ++j) { const int n = (lane >> 3) + 8 * j; const LAS float* s = scr + (8 * c) * 33 + n;
        v4u o; o.x = pk2(s[0 * 33], s[1 * 33]); o.y = pk2(s[2 * 33], s[3 * 33]); o.z = pk2(s[4 * 33], s[5 * 33]); o.w = pk2(s[6 * 33], s[7 * 33]);
        *(v4u*)(WT + (size_t)(n0 + n) * K + k0 + 8 * c) = o; }
    asm volatile("s_waitcnt lgkmcnt(0)" ::: "memory");
}
__device__ __forceinline__ void sincos_d(double a, float& c, float& s) {
    const double q = __builtin_rint(a * 0.6366197723675814); const double r = __builtin_fma(-q, 1.5707963267948966, a) - q * 6.123233995736766e-17;
    const double r2 = r * r;
    double sp = 1.0 / 6227020800.0; sp = sp * r2 - 1.0 / 39916800.0; sp = sp * r2 + 1.0 / 362880.0; sp = sp * r2 - 1.0 / 5040.0; sp = sp * r2 + 1.0 / 120.0; sp = sp * r2 - 1.0 / 6.0; sp = sp * r2 * r + r;
    double cp = 1.0 / 479001600.0; cp = cp * r2 - 1.0 / 3628800.0; cp = cp * r2 + 1.0 / 40320.0; cp = cp * r2 - 1.0 / 720.0; cp = cp * r2 + 1.0 / 24.0; cp = cp * r2 - 0.5; cp = cp * r2 + 1.0;
    const int qi = (int)((long long)q & 3);
    const double cc = (qi == 0) ? cp : (qi == 1) ? -sp : (qi == 2) ? -cp : sp;
    const double ss = (qi == 0) ? sp : (qi == 1) ? cp : (qi == 2) ? -sp : -cp;
    c = (float)cc; s = (float)ss;
}

#define XB_TMO      128
#define XB_XCNT(j)  (256  + 64 * (j))
#define XB_XSUB(j)  (1280 + 64 * (j))
#define XB_XGEN(j)  (2304 + 64 * (j))
#define XB_TOP      3328
#define XB_TOPGEN   3392
#define XCD_BAR_WORDS 3456
#define XB_SPIN_CAP (1u << 18)

__device__ __forceinline__ unsigned xb_ld(unsigned* p)              { return __hip_atomic_load(p, __ATOMIC_RELAXED, __HIP_MEMORY_SCOPE_AGENT); }
__device__ __forceinline__ unsigned xb_add(unsigned* p, unsigned v) { return __hip_atomic_fetch_add(p, v, __ATOMIC_RELAXED, __HIP_MEMORY_SCOPE_AGENT); }
__device__ __forceinline__ unsigned xb_xcc_id() { return (unsigned)__builtin_amdgcn_s_getreg((3 << 11) | 20) & 0xFu; }
#define XB_SPIN(cond, bar) do { unsigned _sp = 0; while (cond) { __builtin_amdgcn_s_sleep(1); \
    if ((++_sp & 255u) == 0u) { if (xb_ld(&(bar)[XB_TMO])) break; if (_sp > XB_SPIN_CAP) { atomicAdd(&(bar)[XB_TMO], 1u); break; } } } } while (0)

struct XcdBarrier {
    unsigned* bar; unsigned x;
    volatile LAS unsigned* st;
};

__device__ __forceinline__ XcdBarrier xcd_barrier_post(unsigned* bar, volatile LAS unsigned* st) {
    XcdBarrier b; b.bar = bar; b.x = xb_xcc_id(); b.st = st;
    if (threadIdx.x == 0) (void)xb_add(&bar[XB_XCNT(b.x)], 1u);
    return b;
}
__device__ __forceinline__ void xcd_barrier_complete(unsigned* bar, unsigned x, unsigned& nloc, unsigned& nx) {
    const unsigned G = gridDim.x * gridDim.y * gridDim.z;
    unsigned sum, cnt, mine, sp = 0u;
    for (;;) {
        sum = 0u; cnt = 0u; mine = 0u;
#pragma unroll
        for (unsigned j = 0; j < 16; ++j) { const unsigned c = xb_ld(&bar[XB_XCNT(j)]); sum += c; cnt += (c > 0u) ? 1u : 0u; mine = (j == x) ? c : mine; }
        if (sum == G) break;
        __builtin_amdgcn_s_sleep(1);
        if ((++sp & 255u) == 0u) { if (xb_ld(&bar[XB_TMO])) break; if (sp > XB_SPIN_CAP) { atomicAdd(&bar[XB_TMO], 1u); break; } }
    }
    nloc = mine > 0u ? mine : 1u; nx = cnt > 0u ? cnt : 1u;
}

__device__ __forceinline__ void xcd_barrier(const XcdBarrier& b) {
    asm volatile("s_waitcnt vmcnt(0)" ::: "memory");
    __syncthreads();
    if (threadIdx.x == 0) {
        unsigned* bar = b.bar;
        __builtin_amdgcn_s_waitcnt(0);
        unsigned nloc = b.st[0], nx = b.st[1];
        if (nloc == 0u) { xcd_barrier_complete(bar, b.x, nloc, nx); b.st[0] = nloc; b.st[1] = nx; }
        const unsigned old = xb_add(&bar[XB_XSUB(b.x)], 1u);
        const unsigned gen = old / nloc;
        if (old + 1u == (gen + 1u) * nloc) {
            __builtin_amdgcn_fence(__ATOMIC_RELEASE, "agent");
            asm volatile("s_waitcnt vmcnt(0)" ::: "memory");
            const unsigned og = xb_add(&bar[XB_TOP], 1u);
            const unsigned tg = og / nx;
            if (og + 1u == (tg + 1u) * nx) xb_add(&bar[XB_TOPGEN], 1u);
            else XB_SPIN(xb_ld(&bar[XB_TOPGEN]) == tg, bar);
            __builtin_amdgcn_fence(__ATOMIC_ACQUIRE, "agent");
            xb_add(&bar[XB_XGEN(b.x)], 1u);
            asm volatile("s_waitcnt vmcnt(0)" ::: "memory");
        } else {
            XB_SPIN(xb_ld(&bar[XB_XGEN(b.x)]) == gen, bar);
            __builtin_amdgcn_fence(__ATOMIC_ACQUIRE, "agent");
            asm volatile("s_waitcnt vmcnt(0)" ::: "memory");
        }
    }
    __syncthreads();
}

struct Args { const float* in[16]; float* out; unsigned char* ws; int ph_lo, ph_hi; };

__global__ void __launch_bounds__(NWAVES * 64, 2) mk_fwd(Args args) {
    extern __shared__ __attribute__((aligned(16))) unsigned char lds[];
    LAS unsigned char* ldsp = (LAS unsigned char*)lds;
    const int tid = threadIdx.x, lane = tid & 63, wave = __builtin_amdgcn_readfirstlane(tid >> 6);
    const int G = gridDim.x, bx = blockIdx.x;
    const int vcu = (G % 8 == 0) ? (bx % 8) * (G / 8) + bx / 8 : bx;
    unsigned char* ws = args.ws;
    float* out = args.out;
    float* tabA = (float*)(ws + WS_TABA);
    unsigned long long* rss = (unsigned long long*)(ws + WS_RSS);
    bf16* XB = (bf16*)(ws + WS_XB); bf16* PROJ = (bf16*)(ws + WS_PROJ); bf16* MIX = (bf16*)(ws + WS_MIX); bf16* HB = (bf16*)(ws + WS_H);
    const int gw = vcu * NWAVES + wave, NGW = G * NWAVES;
    volatile LAS unsigned* MISC = (volatile LAS unsigned*)(ldsp + LDS_MISC);
    if (tid < 2) MISC[tid] = 0u;
    __syncthreads();
    const XcdBarrier bar = xcd_barrier_post((unsigned*)(ws + WS_BAR), MISC);

    const int lo = args.ph_lo, hi = args.ph_hi;
#define IN(k) (lo <= (k) && (k) < hi)
#define SEAM(k) do { if (IN(k) && IN((k) + 1)) { if ((k) == 0) cg::this_grid().sync(); else xcd_barrier(bar); } } while (0)
    if (IN(0)) {

            LAS float* scr = (LAS float*)(ldsp + wave * 16384);
            constexpr int I_IN = 16 * 72, I_OUT = 16 * 32, I_GU = 16 * 176, I_DN = 44 * 32, I_L = I_IN + I_OUT + I_GU + I_DN;
            for (int it = gw; it < 2 * I_L; it += NGW) {
                const int l = it / I_L; int r = it % I_L; bf16* wl = (bf16*)(ws + WS_W + l * W_LAYER);
                if (r < I_IN) { p0_transpose_item(args.in[2] + (size_t)l * DM * INW, args.in[4] + l * DM, DM, INW, (bf16*)((unsigned char*)wl + WO_IN), scr, r, lane); continue; } r -= I_IN;
                if (r < I_OUT) { p0_transpose_item(args.in[3] + (size_t)l * DM * DM, nullptr, DM, DM, (bf16*)((unsigned char*)wl + WO_OUT), scr, r, lane); continue; } r -= I_OUT;
                if (r < I_GU) { p0_transpose_item(args.in[13] + (size_t)l * DM * 2 * DFF, args.in[12] + l * DM, DM, 2 * DFF, (bf16*)((unsigned char*)wl + WO_GU), scr, r, lane); continue; } r -= I_GU;
                p0_transpose_item(args.in[14] + (size_t)l * DFF * DM, nullptr, DFF, DM, (bf16*)((unsigned char*)wl + WO_DN), scr, r, lane);
            }
            for (int m0 = gw; m0 < T; m0 += 2 * NGW) {
                f32x4 v[2][4];
#pragma unroll
                for (int rr = 0; rr < 2; ++rr) { const int m = m0 + rr * NGW; if (m < T) { const float* xrow = (m < TP) ? args.in[0] + (size_t)m * DM : args.in[1] + (size_t)(m - TP) * DM; const f32x4* xr = (const f32x4*)xrow + lane;
#pragma unroll
                    for (int j = 0; j < 4; ++j) v[rr][j] = xr[64 * j]; } }
#pragma unroll
                for (int rr = 0; rr < 2; ++rr) { const int m = m0 + rr * NGW; if (m < T) { float s = 0.f;
#pragma unroll
                    for (int j = 0; j < 4; ++j) s += (v[rr][j].x * v[rr][j].x + v[rr][j].y * v[rr][j].y) + (v[rr][j].z * v[rr][j].z + v[rr][j].w * v[rr][j].w);
                    s = wave_sum(s);
                    v2u* o8 = (v2u*)(XB + (size_t)m * DM) + lane;
#pragma unroll
                    for (int j = 0; j < 4; ++j) { v2u w; w.x = pk2(v[rr][j].x, v[rr][j].y); w.y = pk2(v[rr][j].z, v[rr][j].w); o8[64 * j] = w; }
                    if (lane == 0) rss[m] = (unsigned long long)(s * 4294967296.0f); } }
            }
            const int gt = vcu * (NWAVES * 64) + tid, NGT = G * NWAVES * 64;
            for (int i = gt; i < 4 * T; i += NGT) rss[T + i] = 0ull;
            if (gt < 576) ((unsigned*)(ws + WS_KMAX))[gt] = 0u;
            if (gt < 48) { const int i = gt < 32 ? gt : gt - 32; double inv = 1.0; for (int k = 0; k < (gt < 32 ? i : 2 * i); ++k) inv *= 0.7498942093324558; tabA[gt] = (float)(inv * 0.15915494309189535); }
    }
    SEAM(0);
    if (IN(1)) { constexpr int l = 0; const unsigned char* wl = ws + WS_W + l * W_LAYER; (void)wl;
                pg8::Gemm g{XB, (const bf16*)(wl + WO_IN), T, INW, DM, 32, 256}; pg8::StaticOrder S; S.init(T, INW, G, bx);
                pg8::EpiInProj E{PROJ, rss + (2 * l) * T, args.in[5] + 64 * l, args.in[6] + 64 * l, tabA, (unsigned*)(ws + WS_KMAX) + l * 288};
                pg8::gemm_phase<pg8::EpiInProj, pg8::StaticOrder, true, true>(ldsp, g, S, E);
    }
    SEAM(1);
    if (IN(2)) { constexpr int l = 0; const unsigned char* wl = ws + WS_W + l * W_LAYER; (void)wl;
                float lam, oml;
                { const float a = args.in[7][64 * l + lane] * args.in[8][64 * l + lane], b = args.in[9][64 * l + lane] * args.in[10][64 * l + lane];
                  const float sa = wave_sum(a), sb = wave_sum(b); const float li = (l == 0) ? 0.2f : 0.35550906759096934f;
                  lam = __builtin_amdgcn_exp2f(sa * 1.4426950408889634f) - __builtin_amdgcn_exp2f(sb * 1.4426950408889634f) + li; oml = 1.0f - li; }
                float mfix;
                { float a = __builtin_fabsf(args.in[5][64 * l + lane]), b = __builtin_fabsf(args.in[6][64 * l + lane]);
#pragma unroll
                  for (int o = 1; o < 64; o <<= 1) { a = __builtin_fmaxf(a, __shfl_xor(a, o)); b = __builtin_fmaxf(b, __shfl_xor(b, o)); }
                  mfix = 0.125f * 1.4426950408889634f * 64.0f * 1.01f * a * b; }
                bf16* scrg = (bf16*)(ws + WS_SCR) + (size_t)bx * (256 * 256);
                const float* gsub = args.in[11] + 128 * l;
                for (int i = 0;; ++i) {
                    const int u = i * G + vcu; if (u >= 3840) break;
                    int b, h, qb, rowbase, NT; bool diff;
                    if (u < 256) { b = u >> 6; h = (u >> 4) & 3; qb = u & 15; rowbase = TP + b * 4096; NT = 64; diff = true; }
                    else if (u < 1280) { const int v = u - 256; b = v >> 5; h = (v >> 3) & 3; qb = v & 7; rowbase = b * 2048; NT = 32; diff = true; }
                    else if (u < 1792) { const int v = u - 1280; b = v >> 7; h = (v >> 4) & 7; qb = v & 15; rowbase = TP + b * 4096; NT = 64; diff = false; }
                    else { const int v = u - 1792; b = v >> 6; h = (v >> 3) & 7; qb = v & 7; rowbase = b * 2048; NT = 32; diff = false; }
                    const int q0 = qb * 256;
                    const size_t rq = (size_t)(rowbase + q0) * 64, rk = (size_t)rowbase * 64; constexpr size_t SL = (size_t)T * 64;
                    if (!diff) {
                        attn_body::attn_unit<8>((const attn_body::bf16*)(PROJ + h * SL + rq), (const attn_body::bf16*)(PROJ + (8 + (h >> 2)) * SL + rk), (const attn_body::bf16*)(PROJ + (10 + (h >> 2)) * SL + rk),
                                                (attn_body::bf16*)(MIX + (size_t)(rowbase + q0) * DM + h * 64), DM, NT, (char*)lds, mfix);
                    } else {
                        for (int j = 0; j < 2; ++j)
                            attn_body::attn_unit2<8>((const attn_body::bf16*)(PROJ + (12 + 2 * h + j) * SL + rq), (const attn_body::bf16*)(PROJ + (20 + 2 * h + j) * SL + rk), (const attn_body::bf16*)(PROJ + (28 + 2 * h) * SL + rk),
                                                     (attn_body::bf16*)(scrg + j * 128), 256, NT, (char*)lds, __uint_as_float(((const unsigned*)(ws + WS_KMAX))[l * 288 + (u < 256 ? 32 + b : b) * 8 + 2 * h + j]));
                    }
                    if (diff) {
                        asm volatile("s_waitcnt vmcnt(0)" ::: "memory");
                        __builtin_amdgcn_fence(__ATOMIC_ACQUIRE, "agent");
                        const int r = wave * 32 + (lane >> 1), c0 = (lane & 1) * 64;
                        const bf16* s1 = scrg + r * 256 + c0; const bf16* s2 = s1 + 128;
                        float ss = 0.f;
#pragma unroll
                        for (int c = 0; c < 8; ++c) { const v4u a = *(const volatile v4u*)(s1 + 8 * c), bq = *(const volatile v4u*)(s2 + 8 * c);
#pragma unroll
                            for (int e = 0; e < 4; ++e) { const float d0 = __uint_as_float(a[e] << 16) - lam * __uint_as_float(bq[e] << 16), d1 = __uint_as_float(a[e] & 0xffff0000u) - lam * __uint_as_float(bq[e] & 0xffff0000u); ss += d0 * d0 + d1 * d1; } }
                        ss += __shfl_xor(ss, 1);
                        const float rn = __builtin_amdgcn_rsqf(ss * (1.0f / 128.0f) + 1e-5f) * oml;
                        bf16* mo = MIX + (size_t)(rowbase + q0 + r) * DM + 512 + h * 128 + c0;
#pragma unroll
                        for (int c = 0; c < 8; ++c) { const v4u a = *(const volatile v4u*)(s1 + 8 * c), bq = *(const volatile v4u*)(s2 + 8 * c);
                            const f32x4 g0 = *(const f32x4*)(gsub + c0 + 8 * c), g1 = *(const f32x4*)(gsub + c0 + 8 * c + 4); v4u o;
#pragma unroll
                            for (int e = 0; e < 4; ++e) { const float d0 = __uint_as_float(a[e] << 16) - lam * __uint_as_float(bq[e] << 16), d1 = __uint_as_float(a[e] & 0xffff0000u) - lam * __uint_as_float(bq[e] & 0xffff0000u);
                                const float ga = (e < 2) ? g0[2 * e] : g1[2 * e - 4], gb = (e < 2) ? g0[2 * e + 1] : g1[2 * e - 3];
                                o[e] = pk2(d0 * rn * ga, d1 * rn * gb); }
                            *(v4u*)(mo + 8 * c) = o; }
                        asm volatile("s_waitcnt vmcnt(0)" ::: "memory");
                        __syncthreads();
                    }
                }
    }
    SEAM(2);
    if (IN(3)) { constexpr int l = 0; const unsigned char* wl = ws + WS_W + l * W_LAYER; (void)wl;
                pg8::Gemm g{MIX, (const bf16*)(wl + WO_OUT), T, DM, DM, 128, 256}; pg8::StaticOrder S; S.init(T, DM, G, bx);
                pg8::EpiResid E{XB, rss + (2 * l + 1) * T};
                pg8::gemm_phase<pg8::EpiResid, pg8::StaticOrder, true, true>(ldsp, g, S, E);
    }
    SEAM(3);
    if (IN(4)) { constexpr int l = 0; const unsigned char* wl = ws + WS_W + l * W_LAYER; (void)wl;
                pg8::Gemm g{XB, (const bf16*)(wl + WO_GU), T, 2 * DFF, DM, DFF, 128}; pg8::StaticOrder S; S.init(T, 2 * DFF, G, bx);
                pg8::EpiSwiGLU E{HB, rss + (2 * l + 1) * T};
                pg8::gemm_phase<pg8::EpiSwiGLU, pg8::StaticOrder, true, true>(ldsp, g, S, E);
    }
    SEAM(4);
    if (IN(5)) { constexpr int l = 0; const unsigned char* wl = ws + WS_W + l * W_LAYER; (void)wl;
                pg8::Gemm g{HB, (const bf16*)(wl + WO_DN), T, DM, DFF, 128, 256}; pg8::StaticOrder S; S.init(T, DM, G, bx);
                pg8::EpiResid E{XB, rss + (2 * l + 2) * T};
                pg8::gemm_phase<pg8::EpiResid, pg8::StaticOrder, true, true>(ldsp, g, S, E);
    }
    SEAM(5);
    if (IN(6)) { constexpr int l = 1; const unsigned char* wl = ws + WS_W + l * W_LAYER; (void)wl;
                pg8::Gemm g{XB, (const bf16*)(wl + WO_IN), T, INW, DM, 32, 256}; pg8::StaticOrder S; S.init(T, INW, G, bx);
                pg8::EpiInProj E{PROJ, rss + (2 * l) * T, args.in[5] + 64 * l, args.in[6] + 64 * l, tabA, (unsigned*)(ws + WS_KMAX) + l * 288};
                pg8::gemm_phase<pg8::EpiInProj, pg8::StaticOrder, true, true>(ldsp, g, S, E);
    }
    SEAM(6);
    if (IN(7)) { constexpr int l = 1; const unsigned char* wl = ws + WS_W + l * W_LAYER; (void)wl;
                float lam, oml;
                { const float a = args.in[7][64 * l + lane] * args.in[8][64 * l + lane], b = args.in[9][64 * l + lane] * args.in[10][64 * l + lane];
                  const float sa = wave_sum(a), sb = wave_sum(b); const float li = (l == 0) ? 0.2f : 0.35550906759096934f;
                  lam = __builtin_amdgcn_exp2f(sa * 1.4426950408889634f) - __builtin_amdgcn_exp2f(sb * 1.4426950408889634f) + li; oml = 1.0f - li; }
                float mfix;
                { float a = __builtin_fabsf(args.in[5][64 * l + lane]), b = __builtin_fabsf(args.in[6][64 * l + lane]);
#pragma unroll
                  for (int o = 1; o < 64; o <<= 1) { a = __builtin_fmaxf(a, __shfl_xor(a, o)); b = __builtin_fmaxf(b, __shfl_xor(b, o)); }
                  mfix = 0.125f * 1.4426950408889634f * 64.0f * 1.01f * a * b; }
                bf16* scrg = (bf16*)(ws + WS_SCR) + (size_t)bx * (256 * 256);
                const float* gsub = args.in[11] + 128 * l;
                for (int i = 0;; ++i) {
                    const int u = i * G + vcu; if (u >= 3840) break;
                    int b, h, qb, rowbase, NT; bool diff;
                    if (u < 256) { b = u >> 6; h = (u >> 4) & 3; qb = u & 15; rowbase = TP + b * 4096; NT = 64; diff = true; }
                    else if (u < 1280) { const int v = u - 256; b = v >> 5; h = (v >> 3) & 3; qb = v & 7; rowbase = b * 2048; NT = 32; diff = true; }
                    else if (u < 1792) { const int v = u - 1280; b = v >> 7; h = (v >> 4) & 7; qb = v & 15; rowbase = TP + b * 4096; NT = 64; diff = false; }
                    else { const int v = u - 1792; b = v >> 6; h = (v >> 3) & 7; qb = v & 7; rowbase = b * 2048; NT = 32; diff = false; }
                    const int q0 = qb * 256;
                    const size_t rq = (size_t)(rowbase + q0) * 64, rk = (size_t)rowbase * 64; constexpr size_t SL = (size_t)T * 64;
                    if (!diff) {
                        attn_body::attn_unit<8>((const attn_body::bf16*)(PROJ + h * SL + rq), (const attn_body::bf16*)(PROJ + (8 + (h >> 2)) * SL + rk), (const attn_body::bf16*)(PROJ + (10 + (h >> 2)) * SL + rk),
                                                (attn_body::bf16*)(MIX + (size_t)(rowbase + q0) * DM + h * 64), DM, NT, (char*)lds, mfix);
                    } else {
                        for (int j = 0; j < 2; ++j)
                            attn_body::attn_unit2<8>((const attn_body::bf16*)(PROJ + (12 + 2 * h + j) * SL + rq), (const attn_body::bf16*)(PROJ + (20 + 2 * h + j) * SL + rk), (const attn_body::bf16*)(PROJ + (28 + 2 * h) * SL + rk),
                                                     (attn_body::bf16*)(scrg + j * 128), 256, NT, (char*)lds, __uint_as_float(((const unsigned*)(ws + WS_KMAX))[l * 288 + (u < 256 ? 32 + b : b) * 8 + 2 * h + j]));
                    }
                    if (diff) {
                        asm volatile("s_waitcnt vmcnt(0)" ::: "memory");
                        __builtin_amdgcn_fence(__ATOMIC_ACQUIRE, "agent");
                        const int r = wave * 32 + (lane >> 1), c0 = (lane & 1) * 64;
                        const bf16* s1 = scrg + r * 256 + c0; const bf16* s2 = s1 + 128;
                        float ss = 0.f;
#pragma unroll
                        for (int c = 0; c < 8; ++c) { const v4u a = *(const volatile v4u*)(s1 + 8 * c), bq = *(const volatile v4u*)(s2 + 8 * c);
#pragma unroll
                            for (int e = 0; e < 4; ++e) { const float d0 = __uint_as_float(a[e] << 16) - lam * __uint_as_float(bq[e] << 16), d1 = __uint_as_float(a[e] & 0xffff0000u) - lam * __uint_as_float(bq[e] & 0xffff0000u); ss += d0 * d0 + d1 * d1; } }
                        ss += __shfl_xor(ss, 1);
                        const float rn = __builtin_amdgcn_rsqf(ss * (1.0f / 128.0f) + 1e-5f) * oml;
                        bf16* mo = MIX + (size_t)(rowbase + q0 + r) * DM + 512 + h * 128 + c0;
#pragma unroll
                        for (int c = 0; c < 8; ++c) { const v4u a = *(const volatile v4u*)(s1 + 8 * c), bq = *(const volatile v4u*)(s2 + 8 * c);
                            const f32x4 g0 = *(const f32x4*)(gsub + c0 + 8 * c), g1 = *(const f32x4*)(gsub + c0 + 8 * c + 4); v4u o;
#pragma unroll
                            for (int e = 0; e < 4; ++e) { const float d0 = __uint_as_float(a[e] << 16) - lam * __uint_as_float(bq[e] << 16), d1 = __uint_as_float(a[e] & 0xffff0000u) - lam * __uint_as_float(bq[e] & 0xffff0000u);
                                const float ga = (e < 2) ? g0[2 * e] : g1[2 * e - 4], gb = (e < 2) ? g0[2 * e + 1] : g1[2 * e - 3];
                                o[e] = pk2(d0 * rn * ga, d1 * rn * gb); }
                            *(v4u*)(mo + 8 * c) = o; }
                        asm volatile("s_waitcnt vmcnt(0)" ::: "memory");
                        __syncthreads();
                    }
                }
    }
    SEAM(7);
    if (IN(8)) { constexpr int l = 1; const unsigned char* wl = ws + WS_W + l * W_LAYER; (void)wl;
                pg8::Gemm g{MIX, (const bf16*)(wl + WO_OUT), T, DM, DM, 128, 256}; pg8::StaticOrder S; S.init(T, DM, G, bx);
                pg8::EpiResid E{XB, rss + (2 * l + 1) * T};
                pg8::gemm_phase<pg8::EpiResid, pg8::StaticOrder, true, true>(ldsp, g, S, E);
    }
    SEAM(8);
    if (IN(9)) { constexpr int l = 1; const unsigned char* wl = ws + WS_W + l * W_LAYER; (void)wl;
                pg8::Gemm g{XB, (const bf16*)(wl + WO_GU), T, 2 * DFF, DM, DFF, 128}; pg8::StaticOrder S; S.init(T, 2 * DFF, G, bx);
                pg8::EpiSwiGLU E{HB, rss + (2 * l + 1) * T};
                pg8::gemm_phase<pg8::EpiSwiGLU, pg8::StaticOrder, true, true>(ldsp, g, S, E);
    }
    SEAM(9);
    if (IN(10)) { constexpr int l = 1; const unsigned char* wl = ws + WS_W + l * W_LAYER; (void)wl;
                pg8::Gemm g{HB, (const bf16*)(wl + WO_DN), T, DM, DFF, 128, 256}; pg8::StaticOrder S; S.init(T, DM, G, bx);
                pg8::EpiResid E{XB, rss + (2 * l + 2) * T};
                pg8::gemm_phase<pg8::EpiResid, pg8::StaticOrder, true, true>(ldsp, g, S, E);
    }
    SEAM(10);
    if (IN(NPHASE - 1)) {

            const float* gf = args.in[15];
            f32x4 gv[4];
#pragma unroll
            for (int j = 0; j < 4; ++j) gv[j] = ((const f32x4*)gf)[lane + 64 * j];
            for (int m0 = gw; m0 < T; m0 += 4 * NGW) {
                v2u bb[4][4]; unsigned long long rv[4];
#pragma unroll
                for (int rr = 0; rr < 4; ++rr) { const int m = m0 + rr * NGW; if (m < T) { const v2u* xi = (const v2u*)(XB + (size_t)m * DM) + lane; rv[rr] = rss[4 * T + m];
#pragma unroll
                    for (int j = 0; j < 4; ++j) bb[rr][j] = xi[64 * j]; } }
#pragma unroll
                for (int rr = 0; rr < 4; ++rr) { const int m = m0 + rr * NGW; if (m < T) { f32x4* xr = (f32x4*)(out + (size_t)m * DM) + lane; const float rs = __builtin_amdgcn_rsqf((float)rv[rr] * (2.3283064365386963e-10f / 1024.0f) + 1e-6f);
#pragma unroll
                    for (int j = 0; j < 4; ++j) { const v2u b = bb[rr][j]; f32x4 x; x.x = __uint_as_float(b.x << 16); x.y = __uint_as_float(b.x & 0xffff0000u); x.z = __uint_as_float(b.y << 16); x.w = __uint_as_float(b.y & 0xffff0000u); xr[64 * j] = x * rs * gv[j]; } } }
            }
    }
#undef IN
#undef SEAM
}

#ifndef MK_MULTI
#define MK_MULTI 0
#endif
extern "C" void kernel_launch(void* const* d_in, const int* in_sizes, int n_in, void* d_out, int out_size, void* d_ws, size_t ws_size, hipStream_t stream) {
    static int grid = 0;
    if (grid == 0) {
        if (n_in != 16 || out_size != T * DM || ws_size < WS_END) { fprintf(stderr, "kernel_launch: unexpected shapes (n_in %d out %d ws %zu)\n", n_in, out_size, ws_size); grid = -1; return; }
        int dev = 0, cus = 0, per_cu = 0;
        hipGetDevice(&dev); hipDeviceGetAttribute(&cus, hipDeviceAttributeMultiprocessorCount, dev);
        if (hipFuncSetAttribute((const void*)mk_fwd, hipFuncAttributeMaxDynamicSharedMemorySize, LDS_BYTES) != hipSuccess) { fprintf(stderr, "kernel_launch: hipFuncSetAttribute failed\n"); grid = -1; return; }
        if (hipOccupancyMaxActiveBlocksPerMultiprocessor(&per_cu, (const void*)mk_fwd, NWAVES * 64, LDS_BYTES) != hipSuccess || per_cu < 1) { fprintf(stderr, "kernel_launch: occupancy query says %d\n", per_cu); per_cu = 1; }
        (void)hipGetLastError();
        grid = cus * 1;
    }
    if (grid < 0) return;
    Args a{};
    for (int i = 0; i < 16; ++i) a.in[i] = (const float*)d_in[i];
    a.out = (float*)d_out; a.ws = (unsigned char*)d_ws;
#if MK_MULTI
    for (int ph = 0; ph < NPHASE; ++ph) { a.ph_lo = ph; a.ph_hi = ph + 1; hipLaunchKernelGGL(mk_fwd, dim3(grid), dim3(NWAVES * 64), LDS_BYTES, stream, a); }
#else
    a.ph_lo = 0; a.ph_hi = NPHASE;
    void* kargs[] = {&a};
    if (hipMemsetAsync((char*)d_ws + WS_BAR, 0, 16384, stream) != hipSuccess) { fprintf(stderr, "kernel_launch: memset of the barrier words failed\n"); return; }
    hipError_t e = hipLaunchCooperativeKernel((const void*)mk_fwd, dim3(grid), dim3(NWAVES * 64), kargs, LDS_BYTES, stream);
    if (e != hipSuccess) fprintf(stderr, "cooperative launch failed: %s (grid %d)\n", hipGetErrorString(e), grid);
#endif
}
```

```cpp
#include <hip/hip_runtime.h>
#include <hip/hip_cooperative_groups.h>
#include <cstdio>
#include <cstdint>
namespace pg8 {
#define PG8_LAS __attribute__((address_space(3)))
typedef unsigned short bf16_t;
typedef short bf16x8 __attribute__((ext_vector_type(8)));
typedef float f32x4 __attribute__((ext_vector_type(4)));
typedef unsigned u32x4 __attribute__((ext_vector_type(4)));
constexpr int BM = 256, BK = 64, HALF = 128, HTB = HALF * BK * 2  , STAGE_BYTES = 8 * HTB, NXCD = 8, WGM = 8;

__host__ __device__ __forceinline__ int lds_byte(int r, int c) { const int st = (r >> 4) * 2 + (c >> 5), rr = r & 15, cc = c & 31, ob = rr * 64 + cc * 2; return st * 1024 + (ob ^ (((ob >> 9) & 1) << 5)); }
__host__ __device__ __forceinline__ void stage_rc(int b, int& R, int& C) { const int st = b / 1024, sb = b % 1024, swz = sb ^ (((sb >> 9) & 1) << 5); R = (st >> 1) * 16 + swz / 64; C = (st & 1) * 32 + (swz % 64) / 2; }
__host__ __device__ __forceinline__ int perm32(int rho) { const int n = rho >> 4, i = rho & 15; return 8 * (i >> 2) + 4 * n + (i & 3); }

struct Unit { int pm, pn; };
struct Gemm { const bf16_t* A; const bf16_t* Bt; int M, N, K, hB, tB; };

struct StaticOrder {
    int nM, nN, nwg, G, c;
    __host__ __device__ void init(int M, int N, int G_, int c_) { nM = M / BM; nN = N / BM; nwg = nM * nN; G = G_; c = c_; }
    __host__ __device__ bool next(int i, Unit& u) const {
        const long L = (long)i * G + c; if (L >= nwg) return false;
        int wgid = (int)L; { const int q = nwg / NXCD, r = nwg % NXCD, xcd = wgid % NXCD, off = wgid / NXCD; wgid = (xcd < r ? xcd * (q + 1) : r * (q + 1) + (xcd - r) * q) + off; }
        const int nig = WGM * nN, gid = wgid / nig, fm = gid * WGM, gsz = (nM - fm) < WGM ? (nM - fm) : WGM;
        u.pm = fm + ((wgid % nig) % gsz); u.pn = (wgid % nig) / gsz; return true;
    }
    __device__ __forceinline__ void a_ready(const Unit&) const {}
    __device__ __forceinline__ void done(const Unit&) const {}
};

__device__ __forceinline__ unsigned cvt_pk_bf16(float lo, float hi) { unsigned r; asm volatile("v_cvt_pk_bf16_f32 %0, %1, %2" : "=v"(r) : "v"(lo), "v"(hi)); return r; }
typedef unsigned u32x2 __attribute__((ext_vector_type(2)));
constexpr float QSCALE = 0.125f * 1.4426950408889634f;
constexpr int TPROMPT = 65536;
constexpr int RSS_LDS = STAGE_BYTES + 128;

struct EpiInProj {
    static constexpr int BMAP = 2; static constexpr bool AFTER_DRAIN = false;
    bf16_t* P; const unsigned long long* rss; const float* gq; const float* gk; const float* frq; unsigned* kmax;
    __device__ __forceinline__ void pre(PG8_LAS unsigned char*, const Unit&, int, int) const {}
    __device__ __forceinline__ void operator()(const f32x4 (&acc)[2][2][4][2], const Unit& u, int wr, int wc, int fr, int fq, PG8_LAS unsigned char* lds) const {
        const int slot = u.pn * 4 + wc;
        const int type = slot < 8 ? 0 : slot < 10 ? 1 : slot < 12 ? 2 : slot < 20 ? 3 : slot < 28 ? 4 : 2;
        const int colbase = u.pn * 256 + wc * 64 + ((fq & 1) << 4) + ((fq >> 1) << 3);
        f32x4 g[2][2], f4[2];
        if (type <= 1) { const float* gp = type == 0 ? gq : gk;
#pragma unroll
            for (int bj = 0; bj < 2; ++bj)
#pragma unroll
                for (int n = 0; n < 2; ++n) g[bj][n] = *(const f32x4*)(gp + 32 * bj + 16 * n + 4 * fq);
            f4[0] = *(const f32x4*)(frq + 32 + 4 * fq); f4[1] = f4[0]; }
        else if (type >= 3) { f4[0] = *(const f32x4*)(frq + 4 * fq); f4[1] = *(const f32x4*)(frq + 16 + 4 * fq); }
        const int tmask = (u.pm * BM < TPROMPT) ? 2047 : 4095;
        float kmx = 0.f;
#pragma unroll
        for (int ai = 0; ai < 2; ++ai)
#pragma unroll
            for (int m = 0; m < 4; ++m) {
                const int row = u.pm * BM + ai * HALF + wr * 64 + m * 16 + fr; const int t = row & tmask;
                const float rs = __builtin_amdgcn_rsqf((float)rss[row] * (2.3283064365386963e-10f / 1024.0f) + 1e-6f);
                f32x4 v[2][2];
#pragma unroll
                for (int bj = 0; bj < 2; ++bj)
#pragma unroll
                    for (int n = 0; n < 2; ++n) v[bj][n] = acc[ai][bj][m][n] * rs;
                if (type <= 1) {
                    float ss = 0.f;
#pragma unroll
                    for (int bj = 0; bj < 2; ++bj)
#pragma unroll
                        for (int n = 0; n < 2; ++n) { const f32x4 x = v[bj][n]; ss += (x[0] * x[0] + x[1] * x[1]) + (x[2] * x[2] + x[3] * x[3]); }
                    ss += __shfl_xor(ss, 16); ss += __shfl_xor(ss, 32);
                    float rn = __builtin_amdgcn_rsqf(ss * (1.0f / 64.0f) + 1e-6f); if (type == 0) rn *= QSCALE;
#pragma unroll
                    for (int bj = 0; bj < 2; ++bj) { const float pf = (float)(bj == 0 ? (t >> 6) : (t & 63)); f32x4 c, s;
#pragma unroll
                        for (int e = 0; e < 4; ++e) { const float a = __builtin_amdgcn_fractf(pf * f4[0][e]); c[e] = __builtin_amdgcn_cosf(a); s[e] = __builtin_amdgcn_sinf(a); }
                        const f32x4 x1 = v[bj][0] * g[bj][0] * rn, x2 = v[bj][1] * g[bj][1] * rn;
                        v[bj][0] = x1 * c - x2 * s; v[bj][1] = x1 * s + x2 * c; }
                } else if (type >= 3) {
                    const float sc = type == 3 ? QSCALE : 1.0f; const float tf = (float)t;
#pragma unroll
                    for (int n = 0; n < 2; ++n) { f32x4 c, s;
#pragma unroll
                        for (int e = 0; e < 4; ++e) { const float a = __builtin_amdgcn_fractf(tf * f4[n][e]); c[e] = __builtin_amdgcn_cosf(a) * sc; s[e] = __builtin_amdgcn_sinf(a) * sc; }
                        const f32x4 x1 = v[0][n], x2 = v[1][n];
                        v[0][n] = x1 * c - x2 * s; v[1][n] = x1 * s + x2 * c; }
                    if (type == 4) { float ks = 0.f;
#pragma unroll
                        for (int bj = 0; bj < 2; ++bj)
#pragma unroll
                            for (int n = 0; n < 2; ++n) { const f32x4 x = v[bj][n]; ks += (x[0] * x[0] + x[1] * x[1]) + (x[2] * x[2] + x[3] * x[3]); }
                        ks += __shfl_xor(ks, 16); ks += __shfl_xor(ks, 32); kmx = __builtin_fmaxf(kmx, ks); }
                }
                bf16_t* rowp = P + ((size_t)slot * 81920 + row) * 64 + (((fq & 1) << 4) + ((fq >> 1) << 3));
#pragma unroll
                for (int bj = 0; bj < 2; ++bj) {
                    unsigned a0 = cvt_pk_bf16(v[bj][0][0], v[bj][0][1]), a1 = cvt_pk_bf16(v[bj][0][2], v[bj][0][3]), b0 = cvt_pk_bf16(v[bj][1][0], v[bj][1][1]), b1 = cvt_pk_bf16(v[bj][1][2], v[bj][1][3]);
                    { auto r = __builtin_amdgcn_permlane16_swap(a0, b0, false, false); a0 = r[0]; b0 = r[1]; }
                    { auto r = __builtin_amdgcn_permlane16_swap(a1, b1, false, false); a1 = r[0]; b1 = r[1]; }
                    u32x4 w; w.x = a0; w.y = a1; w.z = b0; w.w = b1; *(u32x4*)(rowp + 32 * bj) = w; }
            }
        if (type == 4) {
#pragma unroll
            for (int o = 1; o < 16; o <<= 1) kmx = __builtin_fmaxf(kmx, __shfl_xor(kmx, o));
            const int r0 = u.pm * BM; const int seq = r0 < TPROMPT ? (r0 >> 11) : 32 + ((r0 - TPROMPT) >> 12);
            if (fr == 0 && fq == 0) atomicMax(kmax + seq * 8 + (slot - 20), __float_as_uint(kmx));
        }
    }
};

struct EpiResid {
    static constexpr int BMAP = 0; static constexpr bool AFTER_DRAIN = false;
    bf16_t* xb; unsigned long long* rss_next;
    __device__ __forceinline__ void pre(PG8_LAS unsigned char*, const Unit&, int, int) const {}
    __device__ __forceinline__ void operator()(const f32x4 (&acc)[2][2][4][2], const Unit& u, int wr, int wc, int fr, int fq, PG8_LAS unsigned char*) const {
        const int col0 = u.pn * BM + wc * 32 + 4 * fq;
        u32x2 cur[2][2], nxt[2][2];
        { const size_t off = (size_t)(u.pm * BM + wr * 64 + fr) * 1024 + col0;
#pragma unroll
          for (int bj = 0; bj < 2; ++bj)
#pragma unroll
            for (int n = 0; n < 2; ++n) cur[bj][n] = *(const u32x2*)(xb + off + bj * HALF + n * 16); }
#pragma unroll
        for (int ri = 0; ri < 8; ++ri) {
            const int ai = ri >> 2, m = ri & 3;
            const int row = u.pm * BM + ai * HALF + wr * 64 + m * 16 + fr; float ss = 0.f;
            if (ri < 7) { const int ai2 = (ri + 1) >> 2, m2 = (ri + 1) & 3; const size_t off2 = (size_t)(u.pm * BM + ai2 * HALF + wr * 64 + m2 * 16 + fr) * 1024 + col0;
#pragma unroll
                for (int bj = 0; bj < 2; ++bj)
#pragma unroll
                    for (int n = 0; n < 2; ++n) nxt[bj][n] = *(const u32x2*)(xb + off2 + bj * HALF + n * 16); }
#pragma unroll
            for (int bj = 0; bj < 2; ++bj)
#pragma unroll
                for (int n = 0; n < 2; ++n) { const u32x2 bb = cur[bj][n]; const f32x4 av = acc[ai][bj][m][n];
                    const float o0 = __uint_as_float(bb.x << 16) + av[0], o1 = __uint_as_float(bb.x & 0xffff0000u) + av[1], o2 = __uint_as_float(bb.y << 16) + av[2], o3 = __uint_as_float(bb.y & 0xffff0000u) + av[3];
                    ss += (o0 * o0 + o1 * o1) + (o2 * o2 + o3 * o3);
                    cur[bj][n].x = cvt_pk_bf16(o0, o1); cur[bj][n].y = cvt_pk_bf16(o2, o3); }
#pragma unroll
            for (int bj = 0; bj < 2; ++bj) { unsigned a0 = cur[bj][0].x, a1 = cur[bj][0].y, b0 = cur[bj][1].x, b1 = cur[bj][1].y;
                { auto r = __builtin_amdgcn_permlane16_swap(a0, b0, false, false); a0 = r[0]; b0 = r[1]; }
                { auto r = __builtin_amdgcn_permlane16_swap(a1, b1, false, false); a1 = r[0]; b1 = r[1]; }
                u32x4 w; w.x = a0; w.y = a1; w.z = b0; w.w = b1; *(u32x4*)(xb + (size_t)row * 1024 + u.pn * BM + wc * 32 + bj * HALF + ((fq & 1) << 4) + ((fq >> 1) << 3)) = w; }
            ss += __shfl_xor(ss, 16); ss += __shfl_xor(ss, 32);
            if (fq == 0) atomicAdd(rss_next + row, (unsigned long long)(ss * 4294967296.0f));
#pragma unroll
            for (int bj = 0; bj < 2; ++bj)
#pragma unroll
                for (int n = 0; n < 2; ++n) cur[bj][n] = nxt[bj][n];
        }
    }
};

struct EpiSwiGLU {
    static constexpr int BMAP = 1; static constexpr bool AFTER_DRAIN = false;
    bf16_t* H; const unsigned long long* rss;
    __device__ __forceinline__ void pre(PG8_LAS unsigned char* lds, const Unit& u, int wid, int tid) const {
        __builtin_amdgcn_global_load_lds((const unsigned*)(rss + (size_t)u.pm * BM) + (unsigned)tid, (PG8_LAS unsigned*)(lds + RSS_LDS + wid * 256), 4, 0, 0);
    }
    __device__ __forceinline__ void operator()(const f32x4 (&acc)[2][2][4][2], const Unit& u, int wr, int wc, int fr, int fq, PG8_LAS unsigned char* lds) const {
        const int col0 = u.pn * 128 + wc * 32 + 8 * fq;
#pragma unroll
        for (int ai = 0; ai < 2; ++ai)
#pragma unroll
            for (int m = 0; m < 4; ++m) {
                const int row = u.pm * BM + ai * HALF + wr * 64 + m * 16 + fr;
                const float rs = __builtin_amdgcn_rsqf((float)*(const PG8_LAS unsigned long long*)(lds + RSS_LDS + (ai * HALF + wr * 64 + m * 16 + fr) * 8) * (2.3283064365386963e-10f / 1024.0f) + 1e-6f);
                const float c1 = -1.4426950408889634f * rs, c2 = rs * rs;
                u32x4 w;
#pragma unroll
                for (int n = 0; n < 2; ++n) { const f32x4 g = acc[ai][0][m][n], uu = acc[ai][1][m][n];
                    const f32x4 t = g * c1; f32x4 ex;
#pragma unroll
                    for (int i = 0; i < 4; ++i) ex[i] = __builtin_amdgcn_exp2f(t[i]);
                    const f32x4 d = ex + 1.0f; f32x4 r;
#pragma unroll
                    for (int i = 0; i < 4; ++i) r[i] = __builtin_amdgcn_rcpf(d[i]);
                    const f32x4 o = ((g * uu) * c2) * r;
                    typedef float f2_t __attribute__((ext_vector_type(2))); typedef __bf16 b2_t __attribute__((ext_vector_type(2)));
                    const f2_t lo = {o[0], o[1]}, hi = {o[2], o[3]};
                    w[2 * n] = __builtin_bit_cast(unsigned, __builtin_convertvector(lo, b2_t)); w[2 * n + 1] = __builtin_bit_cast(unsigned, __builtin_convertvector(hi, b2_t)); }
                __builtin_nontemporal_store(w, (u32x4*)(H + (size_t)row * 2816 + col0));
            }
    }
};

template <class Epi, class Sched, bool ALIGN_EPI = false, bool SP2 = false>
__device__ __forceinline__ void gemm_phase(PG8_LAS unsigned char* lds, const Gemm g, const Sched& S, const Epi& E) {
    int tid_l = threadIdx.x; asm volatile("" : "+v"(tid_l)); const int tid = tid_l, wid = __builtin_amdgcn_readfirstlane(tid >> 6), lane = tid & 63, wr = wid >> 2, wc = wid & 3, fr = lane & 15, fq = lane >> 4;
    const int K = g.K, nt = K / BK;
    unsigned voffA[2], voffB[2];
#pragma unroll
    for (int i = 0; i < 2; ++i) { int R, C; stage_rc(tid * 16 + i * 8192, R, C); const int Rb = Epi::BMAP == 1 ? ((R & ~31) + perm32(R & 31)) : (Epi::BMAP == 2 ? (64 * (R >> 5) + (R & 31)) : R);
        voffA[i] = (unsigned)(R * K + C) * 2u; voffB[i] = (unsigned)(Rb * K + C) * 2u; }
    const size_t kstep = (size_t)(BK * 2);
    const size_t hstep = (size_t)HALF * K * 2;
    const size_t tstep = 2 * hstep; const size_t hstepB = (size_t)g.hB * K * 2, tstepB = (size_t)g.tB * K * 2;
    const unsigned ldsw = (unsigned)wid * 1024u;
    const int aoff = lds_byte(wr * 64 + fr, fq * 8), boff = lds_byte(wc * 32 + fr, fq * 8);
#define PG8_SA(b, h) (((b) * 2 + (h)) * HTB)
#define PG8_SB(b, h) ((4 + (b) * 2 + (h)) * HTB)
#define PG8_STAGE(bufoff, gbase, voff) do { _Pragma("unroll") for (int _i = 0; _i < 2; ++_i) \
        __builtin_amdgcn_global_load_lds((const unsigned*)((const char*)(gbase) + (voff)[_i]), (PG8_LAS unsigned*)(lds + (bufoff) + ldsw + _i * 8192), 16, 0, 0); } while (0)
#define PG8_LDA(dst, b, h) do { _Pragma("unroll") for (int m = 0; m < 4; ++m) _Pragma("unroll") for (int k = 0; k < 2; ++k) dst[m][k] = *(const PG8_LAS bf16x8*)(lds + PG8_SA(b, h) + aoff + m * 2048 + k * 1024); } while (0)
#define PG8_LDB(dst, b, h) do { _Pragma("unroll") for (int n = 0; n < 2; ++n) _Pragma("unroll") for (int k = 0; k < 2; ++k) dst[n][k] = *(const PG8_LAS bf16x8*)(lds + PG8_SB(b, h) + boff + n * 2048 + k * 1024); } while (0)
#define PG8_MMA(ai, bj, At, Bt) do { __builtin_amdgcn_s_setprio(1); _Pragma("unroll") for (int m = 0; m < 4; ++m) _Pragma("unroll") for (int n = 0; n < 2; ++n) _Pragma("unroll") for (int k = 0; k < 2; ++k) \
        acc[ai][bj][m][n] = __builtin_amdgcn_mfma_f32_16x16x32_bf16(Bt[n][k], At[m][k], acc[ai][bj][m][n], 0, 0, 0); __builtin_amdgcn_s_setprio(0); } while (0)
#define PG8_WAIT_V(n) asm volatile("s_waitcnt vmcnt(" #n ")" ::: "memory")
#define PG8_WAIT_L(n) asm volatile("s_waitcnt lgkmcnt(" #n ")" ::: "memory")
#define PG8_BAR __builtin_amdgcn_s_barrier()
#define PG8_SCHED __builtin_amdgcn_sched_barrier(0)
    Unit cur, nxt; int ui = 0;
    if (!S.next(0, cur)) return;
    f32x4 acc[2][2][4][2];
#pragma unroll
    for (int a = 0; a < 2; ++a)
#pragma unroll
        for (int b = 0; b < 2; ++b)
#pragma unroll
            for (int m = 0; m < 4; ++m)
#pragma unroll
                for (int n = 0; n < 2; ++n) acc[a][b][m][n] = (f32x4){0.f, 0.f, 0.f, 0.f};
    bf16x8 At[4][2], B0[2][2], B1[2][2];
    const char* cA = (const char*)g.A + (size_t)cur.pm * tstep; const char* cB = (const char*)g.Bt + (size_t)cur.pn * tstepB;
    S.a_ready(cur);
    if constexpr (SP2) {
        PG8_STAGE(PG8_SB(0, 0), cB, voffB); PG8_STAGE(PG8_SB(0, 1), cB + hstepB, voffB); PG8_STAGE(PG8_SA(0, 0), cA, voffA); PG8_STAGE(PG8_SA(0, 1), cA + hstep, voffA);
        if (wr == 1) PG8_BAR;
        PG8_WAIT_V(2); PG8_BAR;
        PG8_STAGE(PG8_SB(1, 0), cB + kstep, voffB); PG8_STAGE(PG8_SA(1, 0), cA + kstep, voffA); PG8_STAGE(PG8_SB(1, 1), cB + hstepB + kstep, voffB);
        PG8_WAIT_V(6); PG8_BAR;
    } else {
        PG8_STAGE(PG8_SB(0, 0), cB, voffB); PG8_STAGE(PG8_SA(0, 0), cA, voffA); PG8_STAGE(PG8_SB(0, 1), cB + hstepB, voffB); PG8_STAGE(PG8_SA(0, 1), cA + hstep, voffA);
        if (wr == 1) PG8_BAR;
        PG8_WAIT_V(4); PG8_BAR;
        PG8_STAGE(PG8_SB(1, 0), cB + kstep, voffB); PG8_STAGE(PG8_SA(1, 0), cA + kstep, voffA); PG8_STAGE(PG8_SB(1, 1), cB + hstepB + kstep, voffB);
        PG8_WAIT_V(6); PG8_BAR;
    }
    for (;;) {
        const bool has_next = S.next(ui + 1, nxt);
        const char* nA = has_next ? (const char*)g.A + (size_t)nxt.pm * tstep : cA; const char* nB = has_next ? (const char*)g.Bt + (size_t)nxt.pn * tstepB : cB;
        for (int t = 0; t < nt; t += 2) {
            const bool last = (t == nt - 2);
            const char* a1 = cA + (size_t)(t + 1) * kstep;
            const char* a2 = last ? nA : cA + (size_t)(t + 2) * kstep; const char* b2 = last ? nB : cB + (size_t)(t + 2) * kstep;
            const char* a3 = a2 + kstep; const char* b3 = b2 + kstep;
            if (last && has_next) S.a_ready(nxt);
            if (last) E.pre(lds, cur, wid, tid);
            if constexpr (SP2) {
            PG8_LDB(B0, 0, 0); PG8_LDB(B1, 0, 1); PG8_SCHED; PG8_LDA(At, 0, 0); PG8_STAGE(PG8_SA(1, 1), a1 + hstep, voffA);
            PG8_WAIT_V(8); PG8_WAIT_L(0); PG8_BAR; PG8_MMA(0, 0, At, B0); PG8_MMA(0, 1, At, B1); PG8_BAR; PG8_SCHED;
            PG8_LDA(At, 0, 1); PG8_STAGE(PG8_SB(0, 0), b2, voffB); PG8_STAGE(PG8_SB(0, 1), b2 + hstepB, voffB); PG8_STAGE(PG8_SA(0, 0), a2, voffA);
            PG8_WAIT_V(8); PG8_WAIT_L(0); PG8_BAR; PG8_MMA(1, 0, At, B0); PG8_MMA(1, 1, At, B1); PG8_BAR; PG8_SCHED;
            PG8_LDB(B0, 1, 0); PG8_LDB(B1, 1, 1); PG8_SCHED; PG8_LDA(At, 1, 0); PG8_STAGE(PG8_SA(0, 1), a2 + hstep, voffA);
            PG8_WAIT_V(8); PG8_WAIT_L(0); PG8_BAR; PG8_MMA(0, 0, At, B0); PG8_MMA(0, 1, At, B1); PG8_BAR; PG8_SCHED;
            PG8_LDA(At, 1, 1); PG8_STAGE(PG8_SB(1, 0), b3, voffB); PG8_STAGE(PG8_SB(1, 1), b3 + hstepB, voffB); PG8_STAGE(PG8_SA(1, 0), a3, voffA);
            PG8_WAIT_V(8); PG8_WAIT_L(0); PG8_BAR; PG8_MMA(1, 0, At, B0); PG8_MMA(1, 1, At, B1); PG8_BAR; PG8_SCHED;
            } else {
            PG8_LDB(B0, 0, 0); PG8_SCHED; PG8_LDA(At, 0, 0); PG8_STAGE(PG8_SA(1, 1), a1 + hstep, voffA);
            PG8_WAIT_L(8); PG8_BAR; PG8_WAIT_L(0); PG8_MMA(0, 0, At, B0); PG8_BAR; PG8_SCHED;
            PG8_LDB(B1, 0, 1); PG8_STAGE(PG8_SB(0, 0), b2, voffB);
            PG8_BAR; PG8_WAIT_L(0); PG8_MMA(0, 1, At, B1); PG8_BAR;
            PG8_LDA(At, 0, 1); PG8_STAGE(PG8_SA(0, 0), a2, voffA);
            PG8_BAR; PG8_WAIT_L(0); PG8_MMA(1, 0, At, B0); PG8_BAR; PG8_SCHED;
            PG8_STAGE(PG8_SB(0, 1), b2 + hstepB, voffB);
            PG8_WAIT_V(6); PG8_BAR; PG8_MMA(1, 1, At, B1); PG8_BAR;
            PG8_LDB(B0, 1, 0); PG8_SCHED; PG8_LDA(At, 1, 0); PG8_STAGE(PG8_SA(0, 1), a2 + hstep, voffA);
            PG8_WAIT_L(8); PG8_BAR; PG8_WAIT_L(0); PG8_MMA(0, 0, At, B0); PG8_BAR; PG8_SCHED;
            PG8_LDB(B1, 1, 1); PG8_STAGE(PG8_SB(1, 0), b3, voffB);
            PG8_BAR; PG8_WAIT_L(0); PG8_MMA(0, 1, At, B1); PG8_BAR;
            PG8_LDA(At, 1, 1); PG8_STAGE(PG8_SA(1, 0), a3, voffA);
            PG8_BAR; PG8_WAIT_L(0); PG8_MMA(1, 0, At, B0); PG8_BAR; PG8_SCHED;
            PG8_STAGE(PG8_SB(1, 1), b3 + hstepB, voffB);
            PG8_WAIT_V(6); PG8_BAR; PG8_MMA(1, 1, At, B1); PG8_BAR;
            }
        }
        if constexpr (ALIGN_EPI) { if (wr == 0) PG8_BAR; }
        if constexpr (!Epi::AFTER_DRAIN) { E(acc, cur, wr, wc, fr, fq, lds); S.done(cur); }
        if (!has_next) break;
#pragma unroll
        for (int a = 0; a < 2; ++a)
#pragma unroll
            for (int b = 0; b < 2; ++b)
#pragma unroll
                for (int m = 0; m < 4; ++m)
#pragma unroll
                    for (int n = 0; n < 2; ++n) acc[a][b][m][n] = (f32x4){0.f, 0.f, 0.f, 0.f};
        cur = nxt; cA = nA; cB = nB; ++ui;
        if constexpr (ALIGN_EPI) { if (wr == 1) PG8_BAR; }
    }
    PG8_WAIT_V(0);
    if constexpr (!ALIGN_EPI) { if (wr == 0) PG8_BAR; }
    PG8_BAR;
    if constexpr (Epi::AFTER_DRAIN) { E.fused(acc, cur, wr, wc, fr, fq, lds, wid, lane); S.done(cur); }
#undef PG8_SA
#undef PG8_SB
#undef PG8_STAGE
#undef PG8_LDA
#undef PG8_LDB
#undef PG8_MMA
#undef PG8_WAIT_V
#undef PG8_WAIT_L
#undef PG8_BAR
#undef PG8_SCHED
}
}
#include <hip/hip_bf16.h>
#include <cmath>
namespace attn_body {
using bf16=__hip_bfloat16;
using bf16x8=__attribute__((ext_vector_type(8)))short;
using s16x4=__attribute__((ext_vector_type(4)))short;
using f32x16=__attribute__((ext_vector_type(16)))float;
using u32x4=__attribute__((ext_vector_type(4)))unsigned;
constexpr int D=64,DM=64; constexpr long VH1=81920L*64;
constexpr int NW=8,QBLK=32,QB=QBLK*NW,KVBLK=64;
constexpr int ATTN_PITCH=DM, ATTN_UNIT_ROWS=QB;
__device__ __forceinline__ int crow(int r,int hi){return (r&3)+8*(r>>2)+4*hi;}
#define SBAR() __builtin_amdgcn_sched_barrier(0)
__device__ __forceinline__ void cmask(f32x16&p0,f32x16&p1,int jb,int qrel,int hi){
  const float NEG=-INFINITY; int kb=64*jb+4*hi;
  #pragma unroll
  for(int r=0;r<16;++r){int kv=kb+(r&3)+8*(r>>2); if(kv>qrel)p0[r]=NEG; if(kv+32>qrel)p1[r]=NEG;}
}

constexpr int NSLOT=3, SLOTB=8192;
constexpr int LDS_K=0, LDS_V=NSLOT*SLOTB, LDS_WS=2*NSLOT*SLOTB, LDS_OST=LDS_WS+NW*64*4, LDS_BYTES=LDS_OST+NW*4096;
constexpr float C2=0.125f*1.4426950408889634f;
__device__ __forceinline__ void glds16(const void*gsrc,unsigned lds_dst){unsigned keep;
  asm volatile("s_mov_b32 %0, m0\n\ts_mov_b32 m0, %2\n\ts_nop 0\n\tglobal_load_lds_dwordx4 %1, off\n\ts_mov_b32 m0, %0":"=&s"(keep):"v"(gsrc),"s"(lds_dst):"memory");}
__device__ __forceinline__ float max3f(float a,float b,float c){float r;asm("v_max3_f32 %0, %1, %2, %3":"=v"(r):"v"(a),"v"(b),"v"(c));return r;}
__device__ __forceinline__ float max2f(float a,float b){float r;asm("v_max_f32_e32 %0, %1, %2":"=v"(r):"v"(a),"v"(b));return r;}
__device__ __forceinline__ float fadd_s(float a,float b){float r;asm("v_add_f32_e32 %0, %1, %2":"=v"(r):"v"(a),"v"(b));return r;}
__device__ __forceinline__ float fsub_s(float a,float b){float r;asm("v_sub_f32_e32 %0, %1, %2":"=v"(r):"v"(a),"v"(b));return r;}
typedef float f32x2_t __attribute__((ext_vector_type(2))); typedef __bf16 bf16x2_t __attribute__((ext_vector_type(2)));
__device__ __forceinline__ unsigned cvtpk_s(float lo,float hi){f32x2_t v={lo,hi};bf16x2_t b=__builtin_convertvector(v,bf16x2_t);return __builtin_bit_cast(unsigned,b);}
#define WAIT_BAR(N) asm volatile("s_waitcnt vmcnt(" #N ") lgkmcnt(0)\n\ts_barrier":::"memory")

__device__ __forceinline__ void qkt(f32x16&p0,f32x16&p1,const char*Kslot,const bf16x8*qr,const f32x16&negm,int r32,int hi){
  const char*kb=Kslot+(r32>>3)*1024+(((hi^((r32>>3)&1))*8+(r32&7))*16);
  #pragma unroll
  for(int d0=0;d0<4;++d0){
    const bf16x8 b0=*reinterpret_cast<const bf16x8*>(kb+d0*256);
    const bf16x8 b1=*reinterpret_cast<const bf16x8*>(kb+d0*256+4096);
    if(d0==0){p0=__builtin_amdgcn_mfma_f32_32x32x16_bf16(b0,qr[0],negm,0,0,0);p1=__builtin_amdgcn_mfma_f32_32x32x16_bf16(b1,qr[0],negm,0,0,0);}
    else{p0=__builtin_amdgcn_mfma_f32_32x32x16_bf16(b0,qr[d0],p0,0,0,0);p1=__builtin_amdgcn_mfma_f32_32x32x16_bf16(b1,qr[d0],p1,0,0,0);}}
}
typedef __attribute__((address_space(3))) const char* lds_cptr;
typedef short v4i16_t __attribute__((ext_vector_type(4)));
__device__ __forceinline__ void kload8(bf16x8*kf,lds_cptr kp){
  #pragma unroll
  for(int d0=0;d0<4;++d0){ kf[2*d0]=*(const __attribute__((address_space(3))) bf16x8*)(kp+d0*256); kf[2*d0+1]=*(const __attribute__((address_space(3))) bf16x8*)(kp+d0*256+4096); }
}
__device__ __forceinline__ void kload2(bf16x8*kf,lds_cptr kp,int j){ kf[2*j]=*(const __attribute__((address_space(3))) bf16x8*)(kp+j*256); kf[2*j+1]=*(const __attribute__((address_space(3))) bf16x8*)(kp+j*256+4096); }
__device__ __forceinline__ s16x4 vtr(lds_cptr p){ return __builtin_bit_cast(s16x4,__builtin_amdgcn_ds_read_tr16_b64_v4i16((__attribute__((address_space(3))) v4i16_t*)p)); }
__device__ __forceinline__ float rowmax(const f32x16&p0,const f32x16&p1){
  float a=max3f(p0[0],p0[1],p1[0]),b=max3f(p0[2],p0[3],p1[1]);a=max3f(a,p1[2],p1[3]);
  #pragma unroll
  for(int r=4;r<16;r+=4){a=max3f(a,p0[r],p0[r+1]);b=max3f(b,p0[r+2],p0[r+3]);a=max3f(a,p1[r],p1[r+1]);b=max3f(b,p1[r+2],p1[r+3]);}
  const float m=max2f(a,b);
  auto rr=__builtin_amdgcn_permlane32_swap(__float_as_uint(m),__float_as_uint(m),false,false);
  return max2f(__uint_as_float(rr[0]),__uint_as_float(rr[1]));
}
__device__ __forceinline__ void pv(f32x16*o,int vb,bf16x8 pa0,bf16x8 pa1,bf16x8 pa2,bf16x8 pa3){
  #pragma unroll
  for(int d0=0;d0<2;++d0){s16x4 lo[4],hi[4];
    #pragma unroll
    for(int ks=0;ks<4;++ks){
      asm volatile("ds_read_b64_tr_b16 %0,%1 offset:%c2":"=&v"(lo[ks]):"v"(vb),"i"(d0*4096+ks*1024):"memory");
      asm volatile("ds_read_b64_tr_b16 %0,%1 offset:%c2":"=&v"(hi[ks]):"v"(vb),"i"(d0*4096+ks*1024+512):"memory");}
    asm volatile("s_waitcnt lgkmcnt(0)":::"memory");SBAR();
    #define PK(k) (bf16x8){lo[k][0],lo[k][1],lo[k][2],lo[k][3],hi[k][0],hi[k][1],hi[k][2],hi[k][3]}
    o[d0]=__builtin_amdgcn_mfma_f32_32x32x16_bf16(pa0,PK(0),o[d0],0,0,0);
    o[d0]=__builtin_amdgcn_mfma_f32_32x32x16_bf16(pa1,PK(1),o[d0],0,0,0);
    o[d0]=__builtin_amdgcn_mfma_f32_32x32x16_bf16(pa2,PK(2),o[d0],0,0,0);
    o[d0]=__builtin_amdgcn_mfma_f32_32x32x16_bf16(pa3,PK(3),o[d0],0,0,0);
    #undef PK
  }
}

#ifndef ATTN_STORE16
#define ATTN_STORE16(p,v) (*(u32x4*)(p)=(v))
#endif
template<int THRL> __device__ __forceinline__ void attn_unit(const bf16*Qp,const bf16*__restrict__ Kp,const bf16*__restrict__ Vp,bf16*Op,int opitch,int NT,char*shm,float mfix){
  int tid_l=threadIdx.x; asm volatile("":"+v"(tid_l)); const int tid=tid_l,lane=tid&63,r32=lane&31,hi=lane>>5; const int wid=__builtin_amdgcn_readfirstlane(tid>>6);
  const bf16*Qw=Qp+(long)(wid*QBLK)*DM;
  const bf16*Kh=Kp,*Vh=Vp;
  const unsigned lds0=(unsigned)(uintptr_t)shm;
  float*wsf=(float*)(shm+LDS_WS)+wid*64;
  const bf16*ksrc=Kh+(long)(8*wid+(lane&7))*DM+((lane>>3)^(wid&1))*8;
  const bf16*vsrc=Vh+(long)(16*(wid&3)+(lane>>2))*DM+(wid>>2)*32+(lane&3)*8;
  const unsigned kdst=lds0+LDS_K+wid*1024, vdst=lds0+LDS_V+wid*1024;
  #define DMA_K(t,slot) glds16(ksrc+(long)(t)*KVBLK*DM,(unsigned)__builtin_amdgcn_readfirstlane(kdst+(slot)))
  #define DMA_V(t,slot) glds16(vsrc+(long)(t)*KVBLK*DM,(unsigned)__builtin_amdgcn_readfirstlane(vdst+(slot)))
  const int vb0=(int)(lds0+LDS_V)+((lane>>4)&1)*32+(lane&3)*8+(4*hi+((lane&15)>>2))*64;
  const char*Kbase=shm+LDS_K; bf16x8 kf[8];
  const lds_cptr shm3=(lds_cptr)shm; const lds_cptr kp0=shm3+LDS_K+(r32>>3)*1024+(((hi^((r32>>3)&1))*8+(r32&7))*16); const lds_cptr vp0=shm3+LDS_V+((lane>>4)&1)*32+(lane&3)*8+(4*hi+((lane&15)>>2))*64;
  DMA_K(0,0);DMA_V(0,0);DMA_K(1,SLOTB);
  bf16x8 qr[4];
  #pragma unroll
  for(int d0=0;d0<4;++d0)qr[d0]=*reinterpret_cast<const bf16x8*>(&Qw[(long)r32*DM+d0*16+hi*8]);
  float mhat=0.f,l_reg=0.f;f32x16 o[2];o[0]=f32x16{};o[1]=f32x16{};float mfl=mfix; asm volatile("":"+v"(mfl)); f32x16 negm; _Pragma("unroll") for(int r=0;r<16;++r)negm[r]=-mfl; asm volatile("":"+v"(negm)); mhat=mfl;
  const int qrel=wid*QBLK+r32;
  #define CMASK(P0,P1,t) do{}while(0)
  bool resc=false;
  #define START(P0,P1) do{ resc=false; _Pragma("unroll") for(int r=0;r<16;++r)P0[r]=__builtin_amdgcn_exp2f(P0[r]); }while(0)
  #define RESC() do{ if(resc){ asm volatile("s_waitcnt lgkmcnt(0)":::"memory"); \
      _Pragma("unroll") for(int d_=0;d_<2;++d_) _Pragma("unroll") for(int r=0;r<16;++r)o[d_][r]*=wsf[crow(r,hi)]; } }while(0)
  f32x16 pA0,pA1,pB0,pB1;
  int sl_prev=0,sl_cur=0,sl_next=SLOTB;
  #define ROT() do{sl_prev=sl_cur;sl_cur=sl_next;sl_next=(sl_next==(NSLOT-1)*SLOTB)?0:sl_next+SLOTB;}while(0)
  DMA_K(2,2*SLOTB);
  WAIT_BAR(3);
  qkt(pA0,pA1,Kbase,qr,negm,r32,hi);asm volatile("s_nop 15\n\ts_nop 7":"+v"(pA0),"+v"(pA1));CMASK(pA0,pA1,0);
  START(pA0,pA1);
  _Pragma("unroll") for(int r=0;r<16;++r)pA1[r]=__builtin_amdgcn_exp2f(pA1[r]);
  WAIT_BAR(0);
  DMA_K(3,0);DMA_V(1,SLOTB);
  ROT();
  kload8(kf,kp0+sl_cur);
  WAIT_BAR(2);
  s16x4 vlo[8],vhi[8]; u32x4 pw0,pw1,pw2,pw3;
  #define PKW(P,B) cvtpk_s(P[B],P[B+1])
  #define PAF(k) __builtin_bit_cast(bf16x8,pw##k)
  #define VFR(i) (bf16x8){vlo[i][0],vlo[i][1],vlo[i][2],vlo[i][3],vhi[i][0],vhi[i][1],vhi[i][2],vhi[i][3]}
  #define PIN(x) asm volatile("":"+v"(x))
  #define MX3(a,b,c) __builtin_fmaxf(__builtin_fmaxf((a),(b)),(c))
  #define GAPA(MF,A0,A1,A2,A3,W0,W1,PW) do{ MF; sacc+=A0; sacc+=A1; sacc+=A2; sacc+=A3; PIN(sacc); W0; W1; PIN(PW); SBAR(); }while(0)
  #define EX(v) __builtin_amdgcn_exp2f(v)
  #define GAPB(MF,X,B) do{ MF; X[B]=EX(X[B]); X[B+1]=EX(X[B+1]); X[B+2]=EX(X[B+2]); X[B+3]=EX(X[B+3]); PIN(X); SBAR(); }while(0)
  #define VRD(i) do{ vlo[i]=vtr(vp_+(((i)>>2)*4096+((i)&3)*1024)); vhi[i]=vtr(vp_+(((i)>>2)*4096+((i)&3)*1024+512)); }while(0)
  #define KRD(G,j) do{ if(G){ kload2(kf,kp0+sl_next,j); SBAR(); } }while(0)
  #define STEP(C0,C1,P0,P1,t,GK,GV,GL) do{ SBAR(); \
    const lds_cptr vp_=vp0+sl_prev; \
    VRD(0); SBAR(); float sacc=(P0[0]+P0[1]); \
    GAPA(C0=__builtin_amdgcn_mfma_f32_32x32x16_bf16(kf[0],qr[0],negm,0,0,0), P0[2],P0[3],P0[4],P0[5],     pw0[0]=PKW(P0,0), pw0[1]=PKW(P0,2), pw0); \
    VRD(4); SBAR(); GAPA(C1=__builtin_amdgcn_mfma_f32_32x32x16_bf16(kf[1],qr[0],negm,0,0,0), P0[6],P0[7],P0[8],P0[9],     pw0[2]=PKW(P0,4), pw0[3]=PKW(P0,6), pw0); \
    VRD(1); SBAR(); GAPA(C0=__builtin_amdgcn_mfma_f32_32x32x16_bf16(kf[2],qr[1],C0,0,0,0),   P0[10],P0[11],P0[12],P0[13], pw1[0]=PKW(P0,8), pw1[1]=PKW(P0,10), pw1); \
    VRD(5); SBAR(); GAPA(C1=__builtin_amdgcn_mfma_f32_32x32x16_bf16(kf[3],qr[1],C1,0,0,0),   P0[14],P0[15],P1[0],P1[1],   pw1[2]=PKW(P0,12),pw1[3]=PKW(P0,14), pw1); \
    VRD(2); SBAR(); GAPA(C0=__builtin_amdgcn_mfma_f32_32x32x16_bf16(kf[4],qr[2],C0,0,0,0),   P1[2],P1[3],P1[4],P1[5],     pw2[0]=PKW(P1,0), pw2[1]=PKW(P1,2), pw2); \
    VRD(6); SBAR(); GAPA(C1=__builtin_amdgcn_mfma_f32_32x32x16_bf16(kf[5],qr[2],C1,0,0,0),   P1[6],P1[7],P1[8],P1[9],     pw2[2]=PKW(P1,4), pw2[3]=PKW(P1,6), pw2); \
    VRD(3); SBAR(); GAPA(C0=__builtin_amdgcn_mfma_f32_32x32x16_bf16(kf[6],qr[3],C0,0,0,0),   P1[10],P1[11],P1[12],P1[13], pw3[0]=PKW(P1,8), pw3[1]=PKW(P1,10), pw3); \
    VRD(7); SBAR(); GAPA(C1=__builtin_amdgcn_mfma_f32_32x32x16_bf16(kf[7],qr[3],C1,0,0,0),   P1[14],P1[15],0.f,0.f,       pw3[2]=PKW(P1,12),pw3[3]=PKW(P1,14), pw3); \
    l_reg+=sacc; \
    if(GK){DMA_K((t)+3,sl_cur);} if(GV){DMA_V((t)+1,sl_next);} \
    CMASK(C0,C1,t); \
    SBAR(); \
    GAPB(o[0]=__builtin_amdgcn_mfma_f32_32x32x16_bf16(PAF(0),VFR(0),o[0],0,0,0), C0,0); \
    GAPB(o[1]=__builtin_amdgcn_mfma_f32_32x32x16_bf16(PAF(0),VFR(4),o[1],0,0,0), C0,4); \
    KRD(GL,0); GAPB(o[0]=__builtin_amdgcn_mfma_f32_32x32x16_bf16(PAF(1),VFR(1),o[0],0,0,0), C0,8); \
    KRD(GL,1); GAPB(o[1]=__builtin_amdgcn_mfma_f32_32x32x16_bf16(PAF(1),VFR(5),o[1],0,0,0), C0,12); \
    KRD(GL,2); GAPB(o[0]=__builtin_amdgcn_mfma_f32_32x32x16_bf16(PAF(2),VFR(2),o[0],0,0,0), C1,0); \
    KRD(GL,3); GAPB(o[1]=__builtin_amdgcn_mfma_f32_32x32x16_bf16(PAF(2),VFR(6),o[1],0,0,0), C1,4); \
    GAPB(o[0]=__builtin_amdgcn_mfma_f32_32x32x16_bf16(PAF(3),VFR(3),o[0],0,0,0), C1,8); \
    GAPB(o[1]=__builtin_amdgcn_mfma_f32_32x32x16_bf16(PAF(3),VFR(7),o[1],0,0,0), C1,12); \
    }while(0)
  int t=1;
  #undef CMASK
  #define CMASK(P0,P1,t) do{}while(0)
  for(;t+5<NT;t+=2){
    STEP(pB0,pB1,pA0,pA1,t,true,true,true);     WAIT_BAR(2); RESC(); ROT();
    STEP(pA0,pA1,pB0,pB1,t+1,true,true,true);   WAIT_BAR(2); RESC(); ROT();
  }
  #undef CMASK
  #define CMASK(P0,P1,t) do{}while(0)
  #define ENDW(tt) do{ if((tt)+3<NT){WAIT_BAR(2);} else if((tt)+2<NT){WAIT_BAR(1);} else {WAIT_BAR(0);} }while(0)
  for(;t+1<NT;t+=2){
    STEP(pB0,pB1,pA0,pA1,t,(t+3<NT),(t+1<NT),(t+1<NT));       ENDW(t);   RESC(); ROT();
    STEP(pA0,pA1,pB0,pB1,t+1,(t+4<NT),(t+2<NT),(t+2<NT));     ENDW(t+1); RESC(); ROT();
  }
  STEP(pB0,pB1,pA0,pA1,NT-1,false,false,false); RESC();
  { float sacc=pB0[0]+pB0[1]; _Pragma("unroll") for(int r=2;r<16;++r)sacc+=pB0[r]; _Pragma("unroll") for(int r=0;r<16;++r)sacc+=pB1[r]; l_reg+=sacc;
    pw0=(u32x4){PKW(pB0,0),PKW(pB0,2),PKW(pB0,4),PKW(pB0,6)};pw1=(u32x4){PKW(pB0,8),PKW(pB0,10),PKW(pB0,12),PKW(pB0,14)};pw2=(u32x4){PKW(pB1,0),PKW(pB1,2),PKW(pB1,4),PKW(pB1,6)};pw3=(u32x4){PKW(pB1,8),PKW(pB1,10),PKW(pB1,12),PKW(pB1,14)};
    SBAR(); pv(o,vb0+sl_cur,PAF(0),PAF(1),PAF(2),PAF(3)); }
  #undef PKW
  #undef PAF
  #undef VFR
  #undef PIN
  #undef MX3
  #undef GAPA
  #undef GAPB
  #undef EX
  #undef VRD
  #undef KRD
  #undef STEP
  #undef ENDW
  {auto rr=__builtin_amdgcn_permlane32_swap(__float_as_uint(l_reg),__float_as_uint(l_reg),false,false);l_reg=__uint_as_float(rr[0])+__uint_as_float(rr[1]);}
  if(hi==0)wsf[32+r32]=l_reg;asm volatile("s_waitcnt lgkmcnt(0)":::"memory");
  float rli[16];
  #pragma unroll
  for(int r=0;r<16;++r)rli[r]=__builtin_amdgcn_rcpf(wsf[32+crow(r,hi)]);
  bf16*Ow=Op+(long)(wid*QBLK)*opitch;
  { bf16*stg=(bf16*)(shm+LDS_OST)+wid*2048;
    #pragma unroll
    for(int r=0;r<16;++r){const int orow=crow(r,hi);
      #pragma unroll
      for(int d0=0;d0<2;++d0)stg[orow*64+d0*32+r32]=__float2bfloat16(o[d0][r]*rli[r]);}
    asm volatile("s_waitcnt lgkmcnt(0)":::"memory");
    #pragma unroll
    for(int i=0;i<4;++i){const int row=i*8+(lane>>3),ch=lane&7; const u32x4 v=*(const u32x4*)(stg+row*64+ch*8); ATTN_STORE16(Ow+(long)row*opitch+ch*8,v);} }
  asm volatile("s_waitcnt lgkmcnt(0)\n\ts_barrier":::"memory");
  #undef DMA_K
  #undef DMA_V
  #undef CMASK
  #undef START
  #undef RESC
  #undef ROT
}
template<int THRL> __device__ __forceinline__ void attn_unit2(const bf16*Qp,const bf16*__restrict__ Kp,const bf16*__restrict__ Vp,bf16*Op,int opitch,int NT,char*shm,float kmax2){
  int tid_l=threadIdx.x; asm volatile("":"+v"(tid_l)); const int tid=tid_l,lane=tid&63,r32=lane&31,hi=lane>>5; const int wid=__builtin_amdgcn_readfirstlane(tid>>6);
  constexpr int L2_V=NSLOT*SLOTB, L2_WS=L2_V+NSLOT*2*SLOTB, L2_OST=L2_WS+NW*64*4;
  const bf16*Qw=Qp+(long)(wid*QBLK)*DM;
  const bf16*Kh=Kp,*Vh=Vp;
  const unsigned lds0=(unsigned)(uintptr_t)shm;
  float*wsf=(float*)(shm+L2_WS)+wid*64;
  const bf16*ksrc=Kh+(long)(8*wid+(lane&7))*DM+((lane>>3)^(wid&1))*8;
  const bf16*vsrc=Vh+(long)(16*(wid&3)+(lane>>2))*DM+(wid>>2)*32+(lane&3)*8;
  const unsigned kdst=lds0+LDS_K+wid*1024, vdst=lds0+L2_V+wid*1024;
  #define DMA_K(t,slot) glds16(ksrc+(long)(t)*KVBLK*DM,(unsigned)__builtin_amdgcn_readfirstlane(kdst+(slot)))
  #define DMA_V(t,slot) do{ glds16(vsrc+(long)(t)*KVBLK*DM,(unsigned)__builtin_amdgcn_readfirstlane(vdst+2*(slot))); glds16(vsrc+VH1+(long)(t)*KVBLK*DM,(unsigned)__builtin_amdgcn_readfirstlane(vdst+2*(slot)+8192)); }while(0)
  const int vb0=(int)(lds0+L2_V)+((lane>>4)&1)*32+(lane&3)*8+(4*hi+((lane&15)>>2))*64;
  const char*Kbase=shm+LDS_K; bf16x8 kf[8];
  const lds_cptr shm3=(lds_cptr)shm; const lds_cptr kp0=shm3+LDS_K+(r32>>3)*1024+(((hi^((r32>>3)&1))*8+(r32&7))*16); const lds_cptr vp0=shm3+L2_V+((lane>>4)&1)*32+(lane&3)*8+(4*hi+((lane&15)>>2))*64;
  DMA_K(0,0);DMA_V(0,0);DMA_K(1,SLOTB);
  bf16x8 qr[4];
  #pragma unroll
  for(int d0=0;d0<4;++d0)qr[d0]=*reinterpret_cast<const bf16x8*>(&Qw[(long)r32*DM+d0*16+hi*8]);
  float mhat=0.f,l_reg=0.f;f32x16 o[4];o[0]=f32x16{};o[1]=f32x16{};o[2]=f32x16{};o[3]=f32x16{};f32x16 negm=f32x16{};asm volatile("":"+v"(negm));
  const int qrel=wid*QBLK+r32;
  #define CMASK(P0,P1,t) do{}while(0)
  bool resc=false;
  #define START(P0,P1) do{ resc=false; _Pragma("unroll") for(int r=0;r<16;++r)P0[r]=__builtin_amdgcn_exp2f(P0[r]); }while(0)
  #define RESC() do{ if(resc){ asm volatile("s_waitcnt lgkmcnt(0)":::"memory"); \
      _Pragma("unroll") for(int d_=0;d_<4;++d_) _Pragma("unroll") for(int r=0;r<16;++r)o[d_][r]*=wsf[crow(r,hi)]; } }while(0)
  f32x16 pA0,pA1,pB0,pB1;
  int sl_prev=0,sl_cur=0,sl_next=SLOTB;
  #define ROT() do{sl_prev=sl_cur;sl_cur=sl_next;sl_next=(sl_next==(NSLOT-1)*SLOTB)?0:sl_next+SLOTB;}while(0)
  DMA_K(2,2*SLOTB);
  { float q2=0.f;
    _Pragma("unroll") for(int d0=0;d0<4;++d0) _Pragma("unroll") for(int e=0;e<8;++e){ const float v=__uint_as_float(((unsigned)(unsigned short)qr[d0][e])<<16); q2+=v*v; }
    auto rr=__builtin_amdgcn_permlane32_swap(__float_as_uint(q2),__float_as_uint(q2),false,false); q2=__uint_as_float(rr[0])+__uint_as_float(rr[1]);
    float kl=kmax2; asm volatile("":"+v"(kl));
    const float mfl=__builtin_amdgcn_sqrtf(q2*kl)*1.02f; mhat=mfl;
    _Pragma("unroll") for(int r=0;r<16;++r)negm[r]=-mfl; asm volatile("":"+v"(negm)); }
  WAIT_BAR(4);
  qkt(pA0,pA1,Kbase,qr,negm,r32,hi);asm volatile("s_nop 15\n\ts_nop 7":"+v"(pA0),"+v"(pA1));CMASK(pA0,pA1,0);
  START(pA0,pA1);
  _Pragma("unroll") for(int r=0;r<16;++r)pA1[r]=__builtin_amdgcn_exp2f(pA1[r]);
  WAIT_BAR(0);
  DMA_K(3,0);DMA_V(1,SLOTB);
  ROT();
  kload8(kf,kp0+sl_cur);
  WAIT_BAR(3);
  s16x4 vlo[8],vhi[8]; u32x4 pw0,pw1,pw2,pw3;
  #define PKW(P,B) cvtpk_s(P[B],P[B+1])
  #define PAF(k) __builtin_bit_cast(bf16x8,pw##k)
  #define VFR(i) (bf16x8){vlo[i][0],vlo[i][1],vlo[i][2],vlo[i][3],vhi[i][0],vhi[i][1],vhi[i][2],vhi[i][3]}
  #define PIN(x) asm volatile("":"+v"(x))
  #define MX3(a,b,c) __builtin_fmaxf(__builtin_fmaxf((a),(b)),(c))
  #define GAPA(MF,A0,A1,A2,A3,W0,W1,PW) do{ MF; sacc+=A0; sacc+=A1; sacc+=A2; sacc+=A3; PIN(sacc); W0; W1; PIN(PW); SBAR(); }while(0)
  #define EX(v) __builtin_amdgcn_exp2f(v)
  #define GAPB(MF,X,B) do{ MF; X[B]=EX(X[B]); X[B+1]=EX(X[B+1]); PIN(X); SBAR(); }while(0)
  #define VRD2(i) do{ vlo[i]=vtr(vp_+8192+(((i)>>2)*4096+((i)&3)*1024)); vhi[i]=vtr(vp_+8192+(((i)>>2)*4096+((i)&3)*1024+512)); SBAR(); }while(0)
  #define VRD(i) do{ vlo[i]=vtr(vp_+(((i)>>2)*4096+((i)&3)*1024)); vhi[i]=vtr(vp_+(((i)>>2)*4096+((i)&3)*1024+512)); }while(0)
  #define KRD(G,j) do{ if(G){ kload2(kf,kp0+sl_next,j); SBAR(); } }while(0)
  #define STEP(C0,C1,P0,P1,t,GK,GV,GL) do{ SBAR(); \
    const lds_cptr vp_=vp0+2*sl_prev; \
    VRD(0); SBAR(); float sacc=(P0[0]+P0[1]); \
    GAPA(C0=__builtin_amdgcn_mfma_f32_32x32x16_bf16(kf[0],qr[0],negm,0,0,0), P0[2],P0[3],P0[4],P0[5],     pw0[0]=PKW(P0,0), pw0[1]=PKW(P0,2), pw0); \
    VRD(4); SBAR(); GAPA(C1=__builtin_amdgcn_mfma_f32_32x32x16_bf16(kf[1],qr[0],negm,0,0,0), P0[6],P0[7],P0[8],P0[9],     pw0[2]=PKW(P0,4), pw0[3]=PKW(P0,6), pw0); \
    VRD(1); SBAR(); GAPA(C0=__builtin_amdgcn_mfma_f32_32x32x16_bf16(kf[2],qr[1],C0,0,0,0),   P0[10],P0[11],P0[12],P0[13], pw1[0]=PKW(P0,8), pw1[1]=PKW(P0,10), pw1); \
    VRD(5); SBAR(); GAPA(C1=__builtin_amdgcn_mfma_f32_32x32x16_bf16(kf[3],qr[1],C1,0,0,0),   P0[14],P0[15],P1[0],P1[1],   pw1[2]=PKW(P0,12),pw1[3]=PKW(P0,14), pw1); \
    VRD(2); SBAR(); GAPA(C0=__builtin_amdgcn_mfma_f32_32x32x16_bf16(kf[4],qr[2],C0,0,0,0),   P1[2],P1[3],P1[4],P1[5],     pw2[0]=PKW(P1,0), pw2[1]=PKW(P1,2), pw2); \
    VRD(6); SBAR(); GAPA(C1=__builtin_amdgcn_mfma_f32_32x32x16_bf16(kf[5],qr[2],C1,0,0,0),   P1[6],P1[7],P1[8],P1[9],     pw2[2]=PKW(P1,4), pw2[3]=PKW(P1,6), pw2); \
    VRD(3); SBAR(); GAPA(C0=__builtin_amdgcn_mfma_f32_32x32x16_bf16(kf[6],qr[3],C0,0,0,0),   P1[10],P1[11],P1[12],P1[13], pw3[0]=PKW(P1,8), pw3[1]=PKW(P1,10), pw3); \
    VRD(7); SBAR(); GAPA(C1=__builtin_amdgcn_mfma_f32_32x32x16_bf16(kf[7],qr[3],C1,0,0,0),   P1[14],P1[15],0.f,0.f,       pw3[2]=PKW(P1,12),pw3[3]=PKW(P1,14), pw3); \
    l_reg+=sacc; \
    if(GK){DMA_K((t)+3,sl_cur);} if(GV){DMA_V((t)+1,sl_next);} \
    CMASK(C0,C1,t); \
    SBAR(); \
    GAPB(o[0]=__builtin_amdgcn_mfma_f32_32x32x16_bf16(PAF(0),VFR(0),o[0],0,0,0), C0,0); VRD2(0); \
    GAPB(o[1]=__builtin_amdgcn_mfma_f32_32x32x16_bf16(PAF(0),VFR(4),o[1],0,0,0), C0,2); VRD2(4); \
    GAPB(o[0]=__builtin_amdgcn_mfma_f32_32x32x16_bf16(PAF(1),VFR(1),o[0],0,0,0), C0,4); VRD2(1); \
    GAPB(o[1]=__builtin_amdgcn_mfma_f32_32x32x16_bf16(PAF(1),VFR(5),o[1],0,0,0), C0,6); VRD2(5); \
    GAPB(o[0]=__builtin_amdgcn_mfma_f32_32x32x16_bf16(PAF(2),VFR(2),o[0],0,0,0), C0,8); VRD2(2); \
    GAPB(o[1]=__builtin_amdgcn_mfma_f32_32x32x16_bf16(PAF(2),VFR(6),o[1],0,0,0), C0,10); VRD2(6); \
    GAPB(o[0]=__builtin_amdgcn_mfma_f32_32x32x16_bf16(PAF(3),VFR(3),o[0],0,0,0), C0,12); VRD2(3); \
    GAPB(o[1]=__builtin_amdgcn_mfma_f32_32x32x16_bf16(PAF(3),VFR(7),o[1],0,0,0), C0,14); VRD2(7); \
    GAPB(o[2]=__builtin_amdgcn_mfma_f32_32x32x16_bf16(PAF(0),VFR(0),o[2],0,0,0), C1,0); \
    GAPB(o[3]=__builtin_amdgcn_mfma_f32_32x32x16_bf16(PAF(0),VFR(4),o[3],0,0,0), C1,2); \
    KRD(GL,0); GAPB(o[2]=__builtin_amdgcn_mfma_f32_32x32x16_bf16(PAF(1),VFR(1),o[2],0,0,0), C1,4); \
    KRD(GL,1); GAPB(o[3]=__builtin_amdgcn_mfma_f32_32x32x16_bf16(PAF(1),VFR(5),o[3],0,0,0), C1,6); \
    KRD(GL,2); GAPB(o[2]=__builtin_amdgcn_mfma_f32_32x32x16_bf16(PAF(2),VFR(2),o[2],0,0,0), C1,8); \
    KRD(GL,3); GAPB(o[3]=__builtin_amdgcn_mfma_f32_32x32x16_bf16(PAF(2),VFR(6),o[3],0,0,0), C1,10); \
    GAPB(o[2]=__builtin_amdgcn_mfma_f32_32x32x16_bf16(PAF(3),VFR(3),o[2],0,0,0), C1,12); \
    GAPB(o[3]=__builtin_amdgcn_mfma_f32_32x32x16_bf16(PAF(3),VFR(7),o[3],0,0,0), C1,14); \
    }while(0)
  int t=1;
  #undef CMASK
  #define CMASK(P0,P1,t) do{}while(0)
  for(;t+5<NT;t+=2){
    STEP(pB0,pB1,pA0,pA1,t,true,true,true);     WAIT_BAR(3); RESC(); ROT();
    STEP(pA0,pA1,pB0,pB1,t+1,true,true,true);   WAIT_BAR(3); RESC(); ROT();
  }
  #undef CMASK
  #define CMASK(P0,P1,t) do{}while(0)
  #define ENDW(tt) do{ if((tt)+3<NT){WAIT_BAR(3);} else if((tt)+2<NT){WAIT_BAR(2);} else {WAIT_BAR(0);} }while(0)
  for(;t+1<NT;t+=2){
    STEP(pB0,pB1,pA0,pA1,t,(t+3<NT),(t+1<NT),(t+1<NT));       ENDW(t);   RESC(); ROT();
    STEP(pA0,pA1,pB0,pB1,t+1,(t+4<NT),(t+2<NT),(t+2<NT));     ENDW(t+1); RESC(); ROT();
  }
  STEP(pB0,pB1,pA0,pA1,NT-1,false,false,false); RESC();
  { float sacc=pB0[0]+pB0[1]; _Pragma("unroll") for(int r=2;r<16;++r)sacc+=pB0[r]; _Pragma("unroll") for(int r=0;r<16;++r)sacc+=pB1[r]; l_reg+=sacc;
    pw0=(u32x4){PKW(pB0,0),PKW(pB0,2),PKW(pB0,4),PKW(pB0,6)};pw1=(u32x4){PKW(pB0,8),PKW(pB0,10),PKW(pB0,12),PKW(pB0,14)};pw2=(u32x4){PKW(pB1,0),PKW(pB1,2),PKW(pB1,4),PKW(pB1,6)};pw3=(u32x4){PKW(pB1,8),PKW(pB1,10),PKW(pB1,12),PKW(pB1,14)};
    SBAR(); pv(o,vb0+2*sl_cur,PAF(0),PAF(1),PAF(2),PAF(3)); pv(o+2,vb0+2*sl_cur+8192,PAF(0),PAF(1),PAF(2),PAF(3)); }
  #undef PKW
  #undef PAF
  #undef VFR
  #undef PIN
  #undef MX3
  #undef GAPA
  #undef GAPB
  #undef EX
  #undef VRD2
  #undef negm
  #undef VRD
  #undef KRD
  #undef STEP
  #undef ENDW
  {auto rr=__builtin_amdgcn_permlane32_swap(__float_as_uint(l_reg),__float_as_uint(l_reg),false,false);l_reg=__uint_as_float(rr[0])+__uint_as_float(rr[1]);}
  if(hi==0)wsf[32+r32]=l_reg;asm volatile("s_waitcnt lgkmcnt(0)":::"memory");
  float rli[16];
  #pragma unroll
  for(int r=0;r<16;++r)rli[r]=__builtin_amdgcn_rcpf(wsf[32+crow(r,hi)]);
  bf16*Ow=Op+(long)(wid*QBLK)*opitch;
  { bf16*stg=(bf16*)(shm+L2_OST)+wid*2048;
    #pragma unroll
    for(int hh=0;hh<2;++hh){
    #pragma unroll
    for(int r=0;r<16;++r){const int orow=crow(r,hi);
      #pragma unroll
      for(int d0=0;d0<2;++d0)stg[orow*64+d0*32+r32]=__float2bfloat16(o[2*hh+d0][r]*rli[r]);}
    asm volatile("s_waitcnt lgkmcnt(0)":::"memory");
    #pragma unroll
    for(int i=0;i<4;++i){const int row=i*8+(lane>>3),ch=lane&7; const u32x4 v=*(const u32x4*)(stg+row*64+ch*8); ATTN_STORE16(Ow+(long)row*opitch+hh*64+ch*8,v);}
    asm volatile("s_waitcnt lgkmcnt(0)":::"memory"); } }
  asm volatile("s_waitcnt lgkmcnt(0)\n\ts_barrier":::"memory");
  #undef DMA_K
  #undef DMA_V
  #undef CMASK
  #undef START
  #undef RESC
  #undef ROT
}
constexpr int ATTN_LDS_BYTES=LDS_BYTES;
#undef SBAR
#undef WAIT_BAR
}

namespace cg = cooperative_groups;
#define LAS __attribute__((address_space(3)))
typedef unsigned short bf16;
typedef unsigned v4u __attribute__((ext_vector_type(4)));
typedef unsigned v2u __attribute__((ext_vector_type(2)));
typedef float f32x4 __attribute__((ext_vector_type(4)));
constexpr int NWAVES = 8;
constexpr int DM = 1024, TP = 65536, TS = 16384, T = TP + TS, INW = 2304, DFF = 2816;
constexpr size_t MiB = 1u << 20;
constexpr size_t WS_TABA = 0, WS_TABT = 64 * 1024, WS_RSS = 764 * MiB, WS_W = 4 * MiB, W_LAYER = 23 * MiB;
constexpr size_t WO_IN = 0, WO_OUT = (size_t)(4.5 * 1048576), WO_GU = (size_t)(6.5 * 1048576), WO_DN = (size_t)(17.5 * 1048576);
constexpr size_t WS_SCR = 52 * MiB, WS_XB = 84 * MiB, WS_PROJ = 244 * MiB, WS_MIX = 604 * MiB, WS_H = 244 * MiB, WS_END = 768 * MiB;
static_assert(WS_RSS + 5 * (size_t)T * 8 <= WS_END && WS_W + 2 * W_LAYER <= WS_SCR && WS_XB + (size_t)T * DM * 2 <= WS_PROJ && WS_PROJ + (size_t)T * INW * 2 <= WS_MIX && WS_H + (size_t)T * DFF * 2 <= WS_RSS, "ws map");
constexpr int LDS_BYTES = 147456;
constexpr int NPHASE = 12;
constexpr size_t WS_BAR = 1 * MiB;
constexpr size_t WS_KMAX = 512 * 1024;
constexpr int LDS_MISC = 131072 + 64;

__device__ __forceinline__ unsigned f2bf(float f) { unsigned u = __builtin_bit_cast(unsigned, f); return (u + 0x7fffu + ((u >> 16) & 1u)) >> 16; }
__device__ __forceinline__ unsigned pk2(float lo, float hi) { return f2bf(lo) | (f2bf(hi) << 16); }
__device__ __forceinline__ float wave_sum(float v) {
#pragma unroll
    for (int o = 1; o < 64; o <<= 1) v += __shfl_xor(v, o);
    return v;
}
__device__ __forceinline__ void p0_transpose_item(const float* W, const float* gain, int K, int N, bf16* WT, LAS float* scr, int item, int lane) {
    const int nblk = N / 32, kb = item / nblk, nb = item % nblk, k0 = 64 * kb, n0 = 32 * nb;
    float wv[32];
#pragma unroll
    for (int i = 0; i < 32; ++i) { const int kk = 2 * i + (lane >> 5); wv[i] = W[(size_t)(k0 + kk) * N + n0 + (lane & 31)]; }
#pragma unroll
    for (int i = 0; i < 32; ++i) { const int kk = 2 * i + (lane >> 5); const float gv = gain ? gain[k0 + kk] : 1.0f; scr[kk * 33 + (lane & 31)] = wv[i] * gv; }
    asm volatile("s_waitcnt lgkmcnt(0)" ::: "memory");
    const int c = lane & 7;
#pragma unroll
    for (int j = 0; j < 4; ++j) { const int n = (lane >> 3) + 8 * j; const LAS float* s = scr + (8 * c) * 33 + n;
        v4u o; o.x = pk2(s[0 * 33], s[1 * 33]); o.y = pk2(s[2 * 33], s[3 * 33]); o.z = pk2(s[4 * 33], s[5 * 33]); o.w = pk2(s[6 * 33], s[7 * 33]);
        *(v4u*)(WT + (size_t)(n0 + n) * K + k0 + 8 * c) = o; }
    asm volatile("s_waitcnt lgkmcnt(0)" ::: "memory");
}
__device__ __forceinline__ void sincos_d(double a, float& c, float& s) {
    const double q = __builtin_rint(a * 0.6366197723675814); const double r = __builtin_fma(-q, 1.5707963267948966, a) - q * 6.123233995736766e-17;
    const double r2 = r * r;
    double sp = 1.0 / 6227020800.0; sp = sp * r2 - 1.0 / 39916800.0; sp = sp * r2 + 1.0 / 362880.0; sp = sp * r2 - 1.0 / 5040.0; sp = sp * r2 + 1.0 / 120.0; sp = sp * r2 - 1.0 / 6.0; sp = sp * r2 * r + r;
    double cp = 1.0 / 479001600.0; cp = cp * r2 - 1.0 / 3628800.0; cp = cp * r2 + 1.0 / 40320.0; cp = cp * r2 - 1.0 / 720.0; cp = cp * r2 + 1.0 / 24.0; cp = cp * r2 - 0.5; cp = cp * r2 + 1.0;
    const int qi = (int)((long long)q & 3);
    const double cc = (qi == 0) ? cp : (qi == 1) ? -sp : (qi == 2) ? -cp : sp;
    const double ss = (qi == 0) ? sp : (qi == 1) ? cp : (qi == 2) ? -sp : -cp;
    c = (float)cc; s = (float)ss;
}

#define XB_TMO      128
#define XB_XCNT(j)  (256  + 64 * (j))
#define XB_XSUB(j)  (1280 + 64 * (j))
#define XB_XGEN(j)  (2304 + 64 * (j))
#define XB_TOP      3328
#define XB_TOPGEN   3392
#define XCD_BAR_WORDS 3456
#define XB_SPIN_CAP (1u << 18)

__device__ __forceinline__ unsigned xb_ld(unsigned* p)              { return __hip_atomic_load(p, __ATOMIC_RELAXED, __HIP_MEMORY_SCOPE_AGENT); }
__device__ __forceinline__ unsigned xb_add(unsigned* p, unsigned v) { return __hip_atomic_fetch_add(p, v, __ATOMIC_RELAXED, __HIP_MEMORY_SCOPE_AGENT); }
__device__ __forceinline__ unsigned xb_xcc_id() { return (unsigned)__builtin_amdgcn_s_getreg((3 << 11) | 20) & 0xFu; }
#define XB_SPIN(cond, bar) do { unsigned _sp = 0; while (cond) { __builtin_amdgcn_s_sleep(1); \
    if ((++_sp & 255u) == 0u) { if (xb_ld(&(bar)[XB_TMO])) break; if (_sp > XB_SPIN_CAP) { atomicAdd(&(bar)[XB_TMO], 1u); break; } } } } while (0)

struct XcdBarrier {
    unsigned* bar; unsigned x;
    volatile LAS unsigned* st;
};

__device__ __forceinline__ XcdBarrier xcd_barrier_post(unsigned* bar, volatile LAS unsigned* st) {
    XcdBarrier b; b.bar = bar; b.x = xb_xcc_id(); b.st = st;
    if (threadIdx.x == 0) (void)xb_add(&bar[XB_XCNT(b.x)], 1u);
    return b;
}
__device__ __forceinline__ void xcd_barrier_complete(unsigned* bar, unsigned x, unsigned& nloc, unsigned& nx) {
    const unsigned G = gridDim.x * gridDim.y * gridDim.z;
    unsigned sum, cnt, mine, sp = 0u;
    for (;;) {
        sum = 0u; cnt = 0u; mine = 0u;
#pragma unroll
        for (unsigned j = 0; j < 16; ++j) { const unsigned c = xb_ld(&bar[XB_XCNT(j)]); sum += c; cnt += (c > 0u) ? 1u : 0u; mine = (j == x) ? c : mine; }
        if (sum == G) break;
        __builtin_amdgcn_s_sleep(1);
        if ((++sp & 255u) == 0u) { if (xb_ld(&bar[XB_TMO])) break; if (sp > XB_SPIN_CAP) { atomicAdd(&bar[XB_TMO], 1u); break; } }
    }
    nloc = mine > 0u ? mine : 1u; nx = cnt > 0u ? cnt : 1u;
}

__device__ __forceinline__ void xcd_barrier(const XcdBarrier& b) {
    asm volatile("s_waitcnt vmcnt(0)" ::: "memory");
    __syncthreads();
    if (threadIdx.x == 0) {
        unsigned* bar = b.bar;
        __builtin_amdgcn_s_waitcnt(0);
        unsigned nloc = b.st[0], nx = b.st[1];
        if (nloc == 0u) { xcd_barrier_complete(bar, b.x, nloc, nx); b.st[0] = nloc; b.st[1] = nx; }
        const unsigned old = xb_add(&bar[XB_XSUB(b.x)], 1u);
        const unsigned gen = old / nloc;
        if (old + 1u == (gen + 1u) * nloc) {
            __builtin_amdgcn_fence(__ATOMIC_RELEASE, "agent");
            asm volatile("s_waitcnt vmcnt(0)" ::: "memory");
            const unsigned og = xb_add(&bar[XB_TOP], 1u);
            const unsigned tg = og / nx;
            if (og + 1u == (tg + 1u) * nx) xb_add(&bar[XB_TOPGEN], 1u);
            else XB_SPIN(xb_ld(&bar[XB_TOPGEN]) == tg, bar);
            __builtin_amdgcn_fence(__ATOMIC_ACQUIRE, "agent");
            xb_add(&bar[XB_XGEN(b.x)], 1u);
            asm volatile("s_waitcnt vmcnt(0)" ::: "memory");
        } else {
            XB_SPIN(xb_ld(&bar[XB_XGEN(b.x)]) == gen, bar);
            __builtin_amdgcn_fence(__ATOMIC_ACQUIRE, "agent");
            asm volatile("s_waitcnt vmcnt(0)" ::: "memory");
        }
    }
    __syncthreads();
}

struct Args { const float* in[16]; float* out; unsigned char* ws; int ph_lo, ph_hi; };

__global__ void __launch_bounds__(NWAVES * 64, 2) mk_fwd(Args args) {
    extern __shared__ __attribute__((aligned(16))) unsigned char lds[];
    LAS unsigned char* ldsp = (LAS unsigned char*)lds;
    const int tid = threadIdx.x, lane = tid & 63, wave = __builtin_amdgcn_readfirstlane(tid >> 6);
    const int G = gridDim.x, bx = blockIdx.x;
    const int vcu = (G % 8 == 0) ? (bx % 8) * (G / 8) + bx / 8 : bx;
    unsigned char* ws = args.ws;
    float* out = args.out;
    float* tabA = (float*)(ws + WS_TABA);
    unsigned long long* rss = (unsigned long long*)(ws + WS_RSS);
    bf16* XB = (bf16*)(ws + WS_XB); bf16* PROJ = (bf16*)(ws + WS_PROJ); bf16* MIX = (bf16*)(ws + WS_MIX); bf16* HB = (bf16*)(ws + WS_H);
    const int gw = vcu * NWAVES + wave, NGW = G * NWAVES;
    volatile LAS unsigned* MISC = (volatile LAS unsigned*)(ldsp + LDS_MISC);
    if (tid < 2) MISC[tid] = 0u;
    __syncthreads();
    const XcdBarrier bar = xcd_barrier_post((unsigned*)(ws + WS_BAR), MISC);

    const int lo = args.ph_lo, hi = args.ph_hi;
#define IN(k) (lo <= (k) && (k) < hi)
#define SEAM(k) do { if (IN(k) && IN((k) + 1)) { if ((k) == 0) cg::this_grid().sync(); else xcd_barrier(bar); } } while (0)
    if (IN(0)) {

            LAS float* scr = (LAS float*)(ldsp + wave * 16384);
            constexpr int I_IN = 16 * 72, I_OUT = 16 * 32, I_GU = 16 * 176, I_DN = 44 * 32, I_L = I_IN + I_OUT + I_GU + I_DN;
            for (int it = gw; it < 2 * I_L; it += NGW) {
                const int l = it / I_L; int r = it % I_L; bf16* wl = (bf16*)(ws + WS_W + l * W_LAYER);
                if (r < I_IN) { p0_transpose_item(args.in[2] + (size_t)l * DM * INW, args.in[4] + l * DM, DM, INW, (bf16*)((unsigned char*)wl + WO_IN), scr, r, lane); continue; } r -= I_IN;
                if (r < I_OUT) { p0_transpose_item(args.in[3] + (size_t)l * DM * DM, nullptr, DM, DM, (bf16*)((unsigned char*)wl + WO_OUT), scr, r, lane); continue; } r -= I_OUT;
                if (r < I_GU) { p0_transpose_item(args.in[13] + (size_t)l * DM * 2 * DFF, args.in[12] + l * DM, DM, 2 * DFF, (bf16*)((unsigned char*)wl + WO_GU), scr, r, lane); continue; } r -= I_GU;
                p0_transpose_item(args.in[14] + (size_t)l * DFF * DM, nullptr, DFF, DM, (bf16*)((unsigned char*)wl + WO_DN), scr, r, lane);
            }
            for (int m0 = gw; m0 < T; m0 += 2 * NGW) {
                f32x4 v[2][4];
#pragma unroll
                for (int rr = 0; rr < 2; ++rr) { const int m = m0 + rr * NGW; if (m < T) { const float* xrow = (m < TP) ? args.in[0] + (size_t)m * DM : args.in[1] + (size_t)(m - TP) * DM; const f32x4* xr = (const f32x4*)xrow + lane;
#pragma unroll
                    for (int j = 0; j < 4; ++j) v[rr][j] = xr[64 * j]; } }
#pragma unroll
                for (int rr = 0; rr < 2; ++rr) { const int m = m0 + rr * NGW; if (m < T) { float s = 0.f;
#pragma unroll
                    for (int j = 0; j < 4; ++j) s += (v[rr][j].x * v[rr][j].x + v[rr][j].y * v[rr][j].y) + (v[rr][j].z * v[rr][j].z + v[rr][j].w * v[rr][j].w);
                    s = wave_sum(s);
                    v2u* o8 = (v2u*)(XB + (size_t)m * DM) + lane;
#pragma unroll
                    for (int j = 0; j < 4; ++j) { v2u w; w.x = pk2(v[rr][j].x, v[rr][j].y); w.y = pk2(v[rr][j].z, v[rr][j].w); o8[64 * j] = w; }
                    if (lane == 0) rss[m] = (unsigned long long)(s * 4294967296.0f); } }
            }
            const int gt = vcu * (NWAVES * 64) + tid, NGT = G * NWAVES * 64;
            for (int i = gt; i < 4 * T; i += NGT) rss[T + i] = 0ull;
            if (gt < 576) ((unsigned*)(ws + WS_KMAX))[gt] = 0u;
            if (gt < 48) { const int i = gt < 32 ? gt : gt - 32; double inv = 1.0; for (int k = 0; k < (gt < 32 ? i : 2 * i); ++k) inv *= 0.7498942093324558; tabA[gt] = (float)(inv * 0.15915494309189535); }
    }
    SEAM(0);
    if (IN(1)) { constexpr int l = 0; const unsigned char* wl = ws + WS_W + l * W_LAYER; (void)wl;
                pg8::Gemm g{XB, (const bf16*)(wl + WO_IN), T, INW, DM, 32, 256}; pg8::StaticOrder S; S.init(T, INW, G, bx);
                pg8::EpiInProj E{PROJ, rss + (2 * l) * T, args.in[5] + 64 * l, args.in[6] + 64 * l, tabA, (unsigned*)(ws + WS_KMAX) + l * 288};
                pg8::gemm_phase<pg8::EpiInProj, pg8::StaticOrder, true, true>(ldsp, g, S, E);
    }
    SEAM(1);
    if (IN(2)) { constexpr int l = 0; const unsigned char* wl = ws + WS_W + l * W_LAYER; (void)wl;
                float lam, oml;
                { const float a = args.in[7][64 * l + lane] * args.in[8][64 * l + lane], b = args.in[9][64 * l + lane] * args.in[10][64 * l + lane];
                  const float sa = wave_sum(a), sb = wave_sum(b); const float li = (l == 0) ? 0.2f : 0.35550906759096934f;
                  lam = __builtin_amdgcn_exp2f(sa * 1.4426950408889634f) - __builtin_amdgcn_exp2f(sb * 1.4426950408889634f) + li; oml = 1.0f - li; }
                float mfix;
                { float a = __builtin_fabsf(args.in[5][64 * l + lane]), b = __builtin_fabsf(args.in[6][64 * l + lane]);
#pragma unroll
                  for (int o = 1; o < 64; o <<= 1) { a = __builtin_fmaxf(a, __shfl_xor(a, o)); b = __builtin_fmaxf(b, __shfl_xor(b, o)); }
                  mfix = 0.125f * 1.4426950408889634f * 64.0f * 1.01f * a * b; }
                bf16* scrg = (bf16*)(ws + WS_SCR) + (size_t)bx * (256 * 256);
                const float* gsub = args.in[11] + 128 * l;
                for (int i = 0;; ++i) {
                    const int u = i * G + vcu; if (u >= 3840) break;
                    int b, h, qb, rowbase, NT; bool diff;
                    if (u < 256) { b = u >> 6; h = (u >> 4) & 3; qb = u & 15; rowbase = TP + b * 4096; NT = 64; diff = true; }
                    else if (u < 1280) { const int v = u - 256; b = v >> 5; h = (v >> 3) & 3; qb = v & 7; rowbase = b * 2048; NT = 32; diff = true; }
                    else if (u < 1792) { const int v = u - 1280; b = v >> 7; h = (v >> 4) & 7; qb = v & 15; rowbase = TP + b * 4096; NT = 64; diff = false; }
                    else { const int v = u - 1792; b = v >> 6; h = (v >> 3) & 7; qb = v & 7; rowbase = b * 2048; NT = 32; diff = false; }
                    const int q0 = qb * 256;
                    const size_t rq = (size_t)(rowbase + q0) * 64, rk = (size_t)rowbase * 64; constexpr size_t SL = (size_t)T * 64;
                    if (!diff) {
                        attn_body::attn_unit<8>((const attn_body::bf16*)(PROJ + h * SL + rq), (const attn_body::bf16*)(PROJ + (8 + (h >> 2)) * SL + rk), (const attn_body::bf16*)(PROJ + (10 + (h >> 2)) * SL + rk),
                                                (attn_body::bf16*)(MIX + (size_t)(rowbase + q0) * DM + h * 64), DM, NT, (char*)lds, mfix);
                    } else {
                        for (int j = 0; j < 2; ++j)
                            attn_body::attn_unit2<8>((const attn_body::bf16*)(PROJ + (12 + 2 * h + j) * SL + rq), (const attn_body::bf16*)(PROJ + (20 + 2 * h + j) * SL + rk), (const attn_body::bf16*)(PROJ + (28 + 2 * h) * SL + rk),
                                                     (attn_body::bf16*)(scrg + j * 128), 256, NT, (char*)lds, __uint_as_float(((const unsigned*)(ws + WS_KMAX))[l * 288 + (u < 256 ? 32 + b : b) * 8 + 2 * h + j]));
                    }
                    if (diff) {
                        asm volatile("s_waitcnt vmcnt(0)" ::: "memory");
                        __builtin_amdgcn_fence(__ATOMIC_ACQUIRE, "agent");
                        const int r = wave * 32 + (lane >> 1), c0 = (lane & 1) * 64;
                        const bf16* s1 = scrg + r * 256 + c0; const bf16* s2 = s1 + 128;
                        float ss = 0.f;
#pragma unroll
                        for (int c = 0; c < 8; ++c) { const v4u a = *(const volatile v4u*)(s1 + 8 * c), bq = *(const volatile v4u*)(s2 + 8 * c);
#pragma unroll
                            for (int e = 0; e < 4; ++e) { const float d0 = __uint_as_float(a[e] << 16) - lam * __uint_as_float(bq[e] << 16), d1 = __uint_as_float(a[e] & 0xffff0000u) - lam * __uint_as_float(bq[e] & 0xffff0000u); ss += d0 * d0 + d1 * d1; } }
                        ss += __shfl_xor(ss, 1);
                        const float rn = __builtin_amdgcn_rsqf(ss * (1.0f / 128.0f) + 1e-5f) * oml;
                        bf16* mo = MIX + (size_t)(rowbase + q0 + r) * DM + 512 + h * 128 + c0;
#pragma unroll
                        for (int c = 0; c < 8; ++c) { const v4u a = *(const volatile v4u*)(s1 + 8 * c), bq = *(const volatile v4u*)(s2 + 8 * c);
                            const f32x4 g0 = *(const f32x4*)(gsub + c0 + 8 * c), g1 = *(const f32x4*)(gsub + c0 + 8 * c + 4); v4u o;
#pragma unroll
                            for (int e = 0; e < 4; ++e) { const float d0 = __uint_as_float(a[e] << 16) - lam * __uint_as_float(bq[e] << 16), d1 = __uint_as_float(a[e] & 0xffff0000u) - lam * __uint_as_float(bq[e] & 0xffff0000u);
                                const float ga = (e < 2) ? g0[2 * e] : g1[2 * e - 4], gb = (e < 2) ? g0[2 * e + 1] : g1[2 * e - 3];
                                o[e] = pk2(d0 * rn * ga, d1 * rn * gb); }
                            *(v4u*)(mo + 8 * c) = o; }
                        asm volatile("s_waitcnt vmcnt(0)" ::: "memory");
                        __syncthreads();
                    }
                }
    }
    SEAM(2);
    if (IN(3)) { constexpr int l = 0; const unsigned char* wl = ws + WS_W + l * W_LAYER; (void)wl;
                pg8::Gemm g{MIX, (const bf16*)(wl + WO_OUT), T, DM, DM, 128, 256}; pg8::StaticOrder S; S.init(T, DM, G, bx);
                pg8::EpiResid E{XB, rss + (2 * l + 1) * T};
                pg8::gemm_phase<pg8::EpiResid, pg8::StaticOrder, true, true>(ldsp, g, S, E);
    }
    SEAM(3);
    if (IN(4)) { constexpr int l = 0; const unsigned char* wl = ws + WS_W + l * W_LAYER; (void)wl;
                pg8::Gemm g{XB, (const bf16*)(wl + WO_GU), T, 2 * DFF, DM, DFF, 128}; pg8::StaticOrder S; S.init(T, 2 * DFF, G, bx);
                pg8::EpiSwiGLU E{HB, rss + (2 * l + 1) * T};
                pg8::gemm_phase<pg8::EpiSwiGLU, pg8::StaticOrder, true, true>(ldsp, g, S, E);
    }
    SEAM(4);
    if (IN(5)) { constexpr int l = 0; const unsigned char* wl = ws + WS_W + l * W_LAYER; (void)wl;
                pg8::Gemm g{HB, (const bf16*)(wl + WO_DN), T, DM, DFF, 128, 256}; pg8::StaticOrder S; S.init(T, DM, G, bx);
                pg8::EpiResid E{XB, rss + (2 * l + 2) * T};
                pg8::gemm_phase<pg8::EpiResid, pg8::StaticOrder, true, true>(ldsp, g, S, E);
    }
    SEAM(5);
    if (IN(6)) { constexpr int l = 1; const unsigned char* wl = ws + WS_W + l * W_LAYER; (void)wl;
                pg8::Gemm g{XB, (const bf16*)(wl + WO_IN), T, INW, DM, 32, 256}; pg8::StaticOrder S; S.init(T, INW, G, bx);
                pg8::EpiInProj E{PROJ, rss + (2 * l) * T, args.in[5] + 64 * l, args.in[6] + 64 * l, tabA, (unsigned*)(ws + WS_KMAX) + l * 288};
                pg8::gemm_phase<pg8::EpiInProj, pg8::StaticOrder, true, true>(ldsp, g, S, E);
    }
    SEAM(6);
    if (IN(7)) { constexpr int l = 1; const unsigned char* wl = ws + WS_W + l * W_LAYER; (void)wl;
                float lam, oml;
                { const float a = args.in[7][64 * l + lane] * args.in[8][64 * l + lane], b = args.in[9][64 * l + lane] * args.in[10][64 * l + lane];
                  const float sa = wave_sum(a), sb = wave_sum(b); const float li = (l == 0) ? 0.2f : 0.35550906759096934f;
                  lam = __builtin_amdgcn_exp2f(sa * 1.4426950408889634f) - __builtin_amdgcn_exp2f(sb * 1.4426950408889634f) + li; oml = 1.0f - li; }
                float mfix;
                { float a = __builtin_fabsf(args.in[5][64 * l + lane]), b = __builtin_fabsf(args.in[6][64 * l + lane]);
#pragma unroll
                  for (int o = 1; o < 64; o <<= 1) { a = __builtin_fmaxf(a, __shfl_xor(a, o)); b = __builtin_fmaxf(b, __shfl_xor(b, o)); }
                  mfix = 0.125f * 1.4426950408889634f * 64.0f * 1.01f * a * b; }
                bf16* scrg = (bf16*)(ws + WS_SCR) + (size_t)bx * (256 * 256);
                const float* gsub = args.in[11] + 128 * l;
                for (int i = 0;; ++i) {
                    const int u = i * G + vcu; if (u >= 3840) break;
                    int b, h, qb, rowbase, NT; bool diff;
                    if (u < 256) { b = u >> 6; h = (u >> 4) & 3; qb = u & 15; rowbase = TP + b * 4096; NT = 64; diff = true; }
                    else if (u < 1280) { const int v = u - 256; b = v >> 5; h = (v >> 3) & 3; qb = v & 7; rowbase = b * 2048; NT = 32; diff = true; }
                    else if (u < 1792) { const int v = u - 1280; b = v >> 7; h = (v >> 4) & 7; qb = v & 15; rowbase = TP + b * 4096; NT = 64; diff = false; }
                    else { const int v = u - 1792; b = v >> 6; h = (v >> 3) & 7; qb = v & 7; rowbase = b * 2048; NT = 32; diff = false; }
                    const int q0 = qb * 256;
                    const size_t rq = (size_t)(rowbase + q0) * 64, rk = (size_t)rowbase * 64; constexpr size_t SL = (size_t)T * 64;
                    if (!diff) {
                        attn_body::attn_unit<8>((const attn_body::bf16*)(PROJ + h * SL + rq), (const attn_body::bf16*)(PROJ + (8 + (h >> 2)) * SL + rk), (const attn_body::bf16*)(PROJ + (10 + (h >> 2)) * SL + rk),
                                                (attn_body::bf16*)(MIX + (size_t)(rowbase + q0) * DM + h * 64), DM, NT, (char*)lds, mfix);
                    } else {
                        for (int j = 0; j < 2; ++j)
                            attn_body::attn_unit2<8>((const attn_body::bf16*)(PROJ + (12 + 2 * h + j) * SL + rq), (const attn_body::bf16*)(PROJ + (20 + 2 * h + j) * SL + rk), (const attn_body::bf16*)(PROJ + (28 + 2 * h) * SL + rk),
                                                     (attn_body::bf16*)(scrg + j * 128), 256, NT, (char*)lds, __uint_as_float(((const unsigned*)(ws + WS_KMAX))[l * 288 + (u < 256 ? 32 + b : b) * 8 + 2 * h + j]));
                    }
                    if (diff) {
                        asm volatile("s_waitcnt vmcnt(0)" ::: "memory");
                        __builtin_amdgcn_fence(__ATOMIC_ACQUIRE, "agent");
                        const int r = wave * 32 + (lane >> 1), c0 = (lane & 1) * 64;
                        const bf16* s1 = scrg + r * 256 + c0; const bf16* s2 = s1 + 128;
                        float ss = 0.f;
#pragma unroll
                        for (int c = 0; c < 8; ++c) { const v4u a = *(const volatile v4u*)(s1 + 8 * c), bq = *(const volatile v4u*)(s2 + 8 * c);
#pragma unroll
                            for (int e = 0; e < 4; ++e) { const float d0 = __uint_as_float(a[e] << 16) - lam * __uint_as_float(bq[e] << 16), d1 = __uint_as_float(a[e] & 0xffff0000u) - lam * __uint_as_float(bq[e] & 0xffff0000u); ss += d0 * d0 + d1 * d1; } }
                        ss += __shfl_xor(ss, 1);
                        const float rn = __builtin_amdgcn_rsqf(ss * (1.0f / 128.0f) + 1e-5f) * oml;
                        bf16* mo = MIX + (size_t)(rowbase + q0 + r) * DM + 512 + h * 128 + c0;
#pragma unroll
                        for (int c = 0; c < 8; ++c) { const v4u a = *(const volatile v4u*)(s1 + 8 * c), bq = *(const volatile v4u*)(s2 + 8 * c);
                            const f32x4 g0 = *(const f32x4*)(gsub + c0 + 8 * c), g1 = *(const f32x4*)(gsub + c0 + 8 * c + 4); v4u o;
#pragma unroll
                            for (int e = 0; e < 4; ++e) { const float d0 = __uint_as_float(a[e] << 16) - lam * __uint_as_float(bq[e] << 16), d1 = __uint_as_float(a[e] & 0xffff0000u) - lam * __uint_as_float(bq[e] & 0xffff0000u);
                                const float ga = (e < 2) ? g0[2 * e] : g1[2 * e - 4], gb = (e < 2) ? g0[2 * e + 1] : g1[2 * e - 3];
                                o[e] = pk2(d0 * rn * ga, d1 * rn * gb); }
                            *(v4u*)(mo + 8 * c) = o; }
                        asm volatile("s_waitcnt vmcnt(0)" ::: "memory");
                        __syncthreads();
                    }
                }
    }
    SEAM(7);
    if (IN(8)) { constexpr int l = 1; const unsigned char* wl = ws + WS_W + l * W_LAYER; (void)wl;
                pg8::Gemm g{MIX, (const bf16*)(wl + WO_OUT), T, DM, DM, 128, 256}; pg8::StaticOrder S; S.init(T, DM, G, bx);
                pg8::EpiResid E{XB, rss + (2 * l + 1) * T};
                pg8::gemm_phase<pg8::EpiResid, pg8::StaticOrder, true, true>(ldsp, g, S, E);
    }
    SEAM(8);
    if (IN(9)) { constexpr int l = 1; const unsigned char* wl = ws + WS_W + l * W_LAYER; (void)wl;
                pg8::Gemm g{XB, (const bf16*)(wl + WO_GU), T, 2 * DFF, DM, DFF, 128}; pg8::StaticOrder S; S.init(T, 2 * DFF, G, bx);
                pg8::EpiSwiGLU E{HB, rss + (2 * l + 1) * T};
                pg8::gemm_phase<pg8::EpiSwiGLU, pg8::StaticOrder, true, true>(ldsp, g, S, E);
    }
    SEAM(9);
    if (IN(10)) { constexpr int l = 1; const unsigned char* wl = ws + WS_W + l * W_LAYER; (void)wl;
                pg8::Gemm g{HB, (const bf16*)(wl + WO_DN), T, DM, DFF, 128, 256}; pg8::StaticOrder S; S.init(T, DM, G, bx);
                pg8::EpiResid E{XB, rss + (2 * l + 2) * T};
                pg8::gemm_phase<pg8::EpiResid, pg8::StaticOrder, true, true>(ldsp, g, S, E);
    }
    SEAM(10);
    if (IN(NPHASE - 1)) {

            const float* gf = args.in[15];
            f32x4 gv[4];
#pragma unroll
            for (int j = 0; j < 4; ++j) gv[j] = ((const f32x4*)gf)[lane + 64 * j];
            for (int m0 = gw; m0 < T; m0 += 4 * NGW) {
                v2u bb[4][4]; unsigned long long rv[4];
#pragma unroll
                for (int rr = 0; rr < 4; ++rr) { const int m = m0 + rr * NGW; if (m < T) { const v2u* xi = (const v2u*)(XB + (size_t)m * DM) + lane; rv[rr] = rss[4 * T + m];
#pragma unroll
                    for (int j = 0; j < 4; ++j) bb[rr][j] = xi[64 * j]; } }
#pragma unroll
                for (int rr = 0; rr < 4; ++rr) { const int m = m0 + rr * NGW; if (m < T) { f32x4* xr = (f32x4*)(out + (size_t)m * DM) + lane; const float rs = __builtin_amdgcn_rsqf((float)rv[rr] * (2.3283064365386963e-10f / 1024.0f) + 1e-6f);
#pragma unroll
                    for (int j = 0; j < 4; ++j) { const v2u b = bb[rr][j]; f32x4 x; x.x = __uint_as_float(b.x << 16); x.y = __uint_as_float(b.x & 0xffff0000u); x.z = __uint_as_float(b.y << 16); x.w = __uint_as_float(b.y & 0xffff0000u); xr[64 * j] = x * rs * gv[j]; } } }
            }
    }
#undef IN
#undef SEAM
}

#ifndef MK_MULTI
#define MK_MULTI 0
#endif
extern "C" void kernel_launch(void* const* d_in, const int* in_sizes, int n_in, void* d_out, int out_size, void* d_ws, size_t ws_size, hipStream_t stream) {
    static int grid = 0;
    if (grid == 0) {
        if (n_in != 16 || out_size != T * DM || ws_size < WS_END) { fprintf(stderr, "kernel_launch: unexpected shapes (n_in %d out %d ws %zu)\n", n_in, out_size, ws_size); grid = -1; return; }
        int dev = 0, cus = 0, per_cu = 0;
        hipGetDevice(&dev); hipDeviceGetAttribute(&cus, hipDeviceAttributeMultiprocessorCount, dev);
        if (hipFuncSetAttribute((const void*)mk_fwd, hipFuncAttributeMaxDynamicSharedMemorySize, LDS_BYTES) != hipSuccess) { fprintf(stderr, "kernel_launch: hipFuncSetAttribute failed\n"); grid = -1; return; }
        if (hipOccupancyMaxActiveBlocksPerMultiprocessor(&per_cu, (const void*)mk_fwd, NWAVES * 64, LDS_BYTES) != hipSuccess || per_cu < 1) { fprintf(stderr, "kernel_launch: occupancy query says %d\n", per_cu); per_cu = 1; }
        (void)hipGetLastError();
        grid = cus * 1;
    }
    if (grid < 0) return;
    Args a{};
    for (int i = 0; i < 16; ++i) a.in[i] = (const float*)d_in[i];
    a.out = (float*)d_out; a.ws = (unsigned char*)d_ws;
#if MK_MULTI
    for (int ph = 0; ph < NPHASE; ++ph) { a.ph_lo = ph; a.ph_hi = ph + 1; hipLaunchKernelGGL(mk_fwd, dim3(grid), dim3(NWAVES * 64), LDS_BYTES, stream, a); }
#else
    a.ph_lo = 0; a.ph_hi = NPHASE;
    void* kargs[] = {&a};
    if (hipMemsetAsync((char*)d_ws + WS_BAR, 0, 16384, stream) != hipSuccess) { fprintf(stderr, "kernel_launch: memset of the barrier words failed\n"); return; }
    hipError_t e = hipLaunchCooperativeKernel((const void*)mk_fwd, dim3(grid), dim3(NWAVES * 64), kargs, LDS_BYTES, stream);
    if (e != hipSuccess) fprintf(stderr, "cooperative launch failed: %s (grid %d)\n", hipGetErrorString(e), grid);
#endif
}
```
